# Optimizing an MI355X kernel written in HIP

```python
import jax, jax.numpy as jnp
from jax import lax
import numpy as np


D_MODEL = 4096
BATCH = 4
SEQ = 4096
DEPTH = 1

PLE_DIM = 256
ATT_HEAD_DIM = 128
ATT_HEADS_PER_GROUP = 8
ATT_GROUPS = ((128, 1), (512, 4), (2048, 16))
N_ATT_GROUPS = 3
ATT_BLOCK = 128
ATT_QKV_WIDTH = N_ATT_GROUPS * ATT_HEADS_PER_GROUP * ATT_HEAD_DIM
ATT_OUT_WIDTH = ATT_HEADS_PER_GROUP * ATT_HEAD_DIM
RET_HEADS = 8
RET_QK_DIM = 256
RET_V_DIM = 512
RET_QK_WIDTH = RET_HEADS * RET_QK_DIM
RET_V_WIDTH = RET_HEADS * RET_V_DIM
RET_CHUNK = 128
RET_ROPE_BASE = 10000.0
IN_WIDTH = 3 * ATT_QKV_WIDTH + 2 * RET_QK_WIDTH + 2 * RET_V_WIDTH + 2 * D_MODEL
FFN_HIDDEN = -(-8 * D_MODEL // (3 * 256)) * 256
LN_EPS = 1e-5
GN_EPS = 1e-6
DEEPNORM_ALPHA = (2 * DEPTH) ** 0.25
DEEPNORM_BETA = (8 * DEPTH) ** -0.25
NEG_INF = -1e30

kernel_name = 'hybrid_dilated_attn_retention_deepnorm_block'


def _layer_norm(t, g, b):
    tf = t.astype(jnp.float32)
    mu = jnp.mean(tf, axis=-1, keepdims=True)
    var = jnp.mean(jnp.square(tf - mu), axis=-1, keepdims=True)
    return ((tf - mu) * lax.rsqrt(var + LN_EPS) * g + b).astype(t.dtype)


def _dilated_window_attention(q, k, v, window, dilation):
    b, s, h, e = q.shape
    w_sub = window // dilation
    span = dilation * ATT_BLOCK
    s_pad = -(-s // span) * span
    n_blk = s_pad // span
    pad = ((0, 0), (0, s_pad - s), (0, 0), (0, 0))

    def blocks(t):
        return jnp.pad(t, pad).reshape(b, n_blk, ATT_BLOCK, dilation, h, e)

    def with_prev(t):
        prev = jnp.pad(t[:, :-1], ((0, 0), (1, 0), (0, 0), (0, 0), (0, 0), (0, 0)))
        return jnp.concatenate([prev, t], axis=2)

    qb = blocks(q)
    kk = with_prev(blocks(k))
    vv = with_prev(blocks(v))
    qi = jnp.arange(ATT_BLOCK)[:, None]
    ki = jnp.arange(2 * ATT_BLOCK)[None, :]
    dist = qi + ATT_BLOCK - ki
    nb = jnp.arange(n_blk)[:, None, None]
    valid = (dist >= 0) & (dist <= w_sub) & (nb * ATT_BLOCK + ki - ATT_BLOCK >= 0)
    scores = jnp.einsum('bnqrhe,bnkrhe->bnrhqk', qb, kk).astype(jnp.float32) * (e ** -0.5)
    scores = jnp.where(valid[None, :, None, None], scores, NEG_INF)
    m = jnp.max(scores, axis=-1, keepdims=True)
    pr = jnp.exp(scores - m)
    denom = jnp.sum(pr, axis=-1)
    o = jnp.einsum('bnrhqk,bnkrhe->bnqrhe', pr.astype(v.dtype), vv).astype(jnp.float32)
    o = o / jnp.transpose(denom, (0, 1, 4, 2, 3))[..., None]
    lse = jnp.transpose(m[..., 0] + jnp.log(denom), (0, 1, 4, 2, 3))
    o = o.reshape(b, s_pad, h, e)[:, :s]
    lse = lse.reshape(b, s_pad, h)[:, :s]
    return o, lse


def _rotary(t, pos):
    half = t.shape[-1] // 2
    inv_freq = RET_ROPE_BASE ** (-jnp.arange(half, dtype=jnp.float32) / half)
    ang = pos[:, None] * inv_freq[None, :]
    cos = jnp.cos(ang)[None, :, None, :]
    sin = jnp.sin(ang)[None, :, None, :]
    t1 = t[..., :half].astype(jnp.float32)
    t2 = t[..., half:].astype(jnp.float32)
    return jnp.concatenate([t1 * cos - t2 * sin, t1 * sin + t2 * cos], axis=-1).astype(t.dtype)


def _retention(q, k, v):
    b, s, h, dk = q.shape
    dv = v.shape[-1]
    c = RET_CHUNK
    nc = s // c
    log_gamma = jnp.log(1.0 - 2.0 ** (-5.0 - jnp.arange(h, dtype=jnp.float32)))
    idx = jnp.arange(c, dtype=jnp.float32)
    diff = idx[:, None] - idx[None, :]
    intra = jnp.where(diff >= 0, jnp.exp(jnp.maximum(diff, 0.0)[None] * log_gamma[:, None, None]), 0.0)
    cross_decay = jnp.exp((idx + 1.0)[None, :] * log_gamma[:, None])[..., None]
    state_decay = jnp.exp((c - 1.0 - idx)[None, :] * log_gamma[:, None])[..., None]
    chunk_decay = jnp.exp(c * log_gamma)[:, None, None]

    def chunks(t):
        return t.reshape(b, nc, c, h, t.shape[-1]).transpose(1, 0, 3, 2, 4)

    def step(state, qkv):
        qc, kc, vc = qkv
        att = jnp.einsum('bhnd,bhmd->bhnm', qc, kc) * intra
        inner = jnp.einsum('bhnm,bhme->bhne', att, vc)
        cross = jnp.einsum('bhnd,bhde->bhne', qc, state) * cross_decay
        new_state = chunk_decay * state + jnp.einsum('bhmd,bhme->bhde', kc * state_decay, vc)
        return new_state, inner + cross

    init = jnp.zeros((b, h, dk, dv), jnp.float32)
    _, out = lax.scan(step, init, (chunks(q), chunks(k), chunks(v)))
    return out.transpose(1, 0, 3, 2, 4).reshape(b, s, h, dv)


def setup_inputs(seed: int = 0) -> dict:
    key = jax.random.key(seed)
    ks = jax.random.split(key, 17)

    def nrm(k, shape, scale):
        return jax.random.normal(k, shape, jnp.float32) * scale

    return {
        'x': nrm(ks[0], (BATCH, SEQ, D_MODEL), 1.0),
        'p': nrm(ks[1], (DEPTH, BATCH, SEQ, PLE_DIM), 1.0),
        'w_in': nrm(ks[2], (DEPTH, D_MODEL, IN_WIDTH), D_MODEL ** -0.5),
        'w_attn_out': nrm(ks[3], (DEPTH, ATT_OUT_WIDTH, D_MODEL), ATT_OUT_WIDTH ** -0.5),
        'w_ret_out': nrm(ks[4], (DEPTH, RET_V_WIDTH, D_MODEL), RET_V_WIDTH ** -0.5),
        'ret_gn_g': 1.0 + nrm(ks[5], (DEPTH, RET_V_WIDTH), 0.02),
        'w_o': nrm(ks[6], (DEPTH, D_MODEL, D_MODEL), DEEPNORM_BETA * D_MODEL ** -0.5),
        'ln1_g': 1.0 + nrm(ks[7], (DEPTH, D_MODEL), 0.02),
        'ln1_b': nrm(ks[8], (DEPTH, D_MODEL), 0.02),
        'w_ffn_gate': nrm(ks[9], (DEPTH, D_MODEL, FFN_HIDDEN), D_MODEL ** -0.5),
        'w_ffn_up': nrm(ks[10], (DEPTH, D_MODEL, FFN_HIDDEN), D_MODEL ** -0.5),
        'w_ffn_down': nrm(ks[11], (DEPTH, FFN_HIDDEN, D_MODEL), DEEPNORM_BETA * FFN_HIDDEN ** -0.5),
        'w_ple_gate': nrm(ks[12], (DEPTH, D_MODEL, D_MODEL), D_MODEL ** -0.5),
        'w_ple_up': nrm(ks[13], (DEPTH, PLE_DIM, D_MODEL), DEEPNORM_BETA * PLE_DIM ** -0.5),
        'ln2_g': 1.0 + nrm(ks[14], (DEPTH, D_MODEL), 0.02),
        'ln2_b': nrm(ks[15], (DEPTH, D_MODEL), 0.02),
    }


def reference(x, p, w_in, w_attn_out, w_ret_out, ret_gn_g, w_o, ln1_g, ln1_b, w_ffn_gate, w_ffn_up,
              w_ffn_down, w_ple_gate, w_ple_up, ln2_g, ln2_b):
    b, s, _ = x.shape
    pos = jnp.arange(s, dtype=jnp.float32)
    widths = [ATT_QKV_WIDTH] * 3 + [RET_QK_WIDTH] * 2 + [RET_V_WIDTH] * 2 + [D_MODEL] * 2
    splits = np.cumsum(widths)[:-1].tolist()
    h = x
    for i in range(DEPTH):
        proj = h @ w_in[i]
        qa, ka, va, qr, kr, vr, gr, gate_att, gate_ret = jnp.split(proj, splits, axis=-1)

        qa = qa.reshape(b, s, N_ATT_GROUPS, ATT_HEADS_PER_GROUP, ATT_HEAD_DIM)
        ka = ka.reshape(b, s, N_ATT_GROUPS, ATT_HEADS_PER_GROUP, ATT_HEAD_DIM)
        va = va.reshape(b, s, N_ATT_GROUPS, ATT_HEADS_PER_GROUP, ATT_HEAD_DIM)
        outs, lses = [], []
        for g, (win, dil) in enumerate(ATT_GROUPS):
            o_g, lse_g = _dilated_window_attention(qa[:, :, g], ka[:, :, g], va[:, :, g], win, dil)
            outs.append(o_g)
            lses.append(lse_g)
        wts = jax.nn.softmax(jnp.stack(lses, axis=0), axis=0)
        o_att = jnp.sum(wts[..., None] * jnp.stack(outs, axis=0), axis=0)
        o_att = o_att.astype(x.dtype).reshape(b, s, ATT_OUT_WIDTH)
        y_att = o_att @ w_attn_out[i]

        qr = _rotary(qr.reshape(b, s, RET_HEADS, RET_QK_DIM), pos)
        kr = _rotary(kr.reshape(b, s, RET_HEADS, RET_QK_DIM), pos) * (RET_QK_DIM ** -0.5)
        vr = vr.reshape(b, s, RET_HEADS, RET_V_DIM)
        r = _retention(qr, kr, vr)
        mu = jnp.mean(r, axis=-1, keepdims=True)
        var = jnp.mean(jnp.square(r - mu), axis=-1, keepdims=True)
        r = ((r - mu) * lax.rsqrt(var + GN_EPS)).reshape(b, s, RET_V_WIDTH) * ret_gn_g[i]
        y_ret = (jax.nn.silu(gr) * r.astype(x.dtype)) @ w_ret_out[i]

        mixed = jax.nn.sigmoid(gate_att) * y_att + jax.nn.sigmoid(gate_ret) * y_ret
        h = _layer_norm(DEEPNORM_ALPHA * h + mixed @ w_o[i], ln1_g[i], ln1_b[i])

        ffn = (jax.nn.silu(h @ w_ffn_gate[i]) * (h @ w_ffn_up[i])) @ w_ffn_down[i]
        ple = jax.nn.sigmoid(h @ w_ple_gate[i]) * (p[i] @ w_ple_up[i])
        h = _layer_norm(DEEPNORM_ALPHA * h + ffn + ple, ln2_g[i], ln2_b[i])
    return h
```

```cpp
#include <hip/hip_runtime.h>
#include <cstdio>
#include <cstdint>

#ifndef MK_N_LAUNCHES
#define MK_N_LAUNCHES 1
#endif
constexpr int N_PHASES = 11;

#define GAS __attribute__((address_space(1)))
#define LAS __attribute__((address_space(3)))
typedef unsigned short bf16;
typedef short bf16x8 __attribute__((ext_vector_type(8)));
typedef float f32x4 __attribute__((ext_vector_type(4)));
typedef float f32x16 __attribute__((ext_vector_type(16)));
typedef unsigned u32x4 __attribute__((ext_vector_type(4)));
typedef unsigned u32x2 __attribute__((ext_vector_type(2)));
typedef __bf16 bf16x2_t __attribute__((ext_vector_type(2)));
typedef float f32x2_t __attribute__((ext_vector_type(2)));
typedef GAS unsigned gu32;
#define RLX_AGENT __ATOMIC_RELAXED, __HIP_MEMORY_SCOPE_AGENT
#define LDS_WAIT() asm volatile("s_waitcnt lgkmcnt(0)" ::: "memory")
#define VM_WAIT() asm volatile("s_waitcnt vmcnt(0)" ::: "memory")

constexpr int M = 16384, D = 4096, SEQ = 4096, PLE = 256, FF = 11008, NIN = 29696;
constexpr float ALPHA = 1.189207115002721f;
constexpr float QSCALE = 0.12751743082459868f;
constexpr float LN_EPS = 1e-5f, GN_EPS = 1e-6f;
__device__ const float LOG2G[8] = {-4.580368961312e-02f, -2.272007650008e-02f, -1.131531322783e-02f, -5.646563141142e-03f, -2.820519062379e-03f, -1.409570254671e-03f, -7.046129765894e-04f, -3.522634716290e-04f};
__device__ const float INVF[128] = {
1.000000000e+00f, 9.305720329e-01f, 8.659643531e-01f, 8.058421612e-01f, 7.498942614e-01f, 6.978306174e-01f, 6.493816376e-01f, 6.042963862e-01f, 5.623413324e-01f, 5.232990980e-01f, 4.869675338e-01f, 4.531583786e-01f, 4.216965139e-01f, 3.924189806e-01f, 3.651741147e-01f, 3.398208320e-01f, 3.162277639e-01f, 2.942726910e-01f, 2.738419771e-01f, 2.548296750e-01f, 2.371373773e-01f, 2.206734121e-01f, 2.053525001e-01f, 1.910953075e-01f, 1.778279394e-01f, 1.654817164e-01f, 1.539926529e-01f, 1.433012486e-01f, 1.333521307e-01f, 1.240937784e-01f, 1.154782027e-01f, 1.074607819e-01f, 1.000000015e-01f, 9.305720776e-02f, 8.659642935e-02f, 8.058421314e-02f, 7.498941571e-02f, 6.978306174e-02f, 6.493816525e-02f, 6.042964011e-02f, 5.623413250e-02f, 5.232991278e-02f, 4.869675264e-02f, 4.531583562e-02f, 4.216965288e-02f, 3.924189508e-02f, 3.651741147e-02f, 3.398208320e-02f, 3.162277490e-02f, 2.942727134e-02f, 2.738419734e-02f, 2.548296750e-02f, 2.371373773e-02f, 2.206734009e-02f, 2.053525113e-02f, 1.910952851e-02f, 1.778279431e-02f, 1.654816978e-02f, 1.539926510e-02f, 1.433012541e-02f, 1.333521493e-02f, 1.240937784e-02f, 1.154782064e-02f, 1.074607857e-02f, 9.999999776e-03f, 9.305720218e-03f, 8.659643121e-03f, 8.058422245e-03f, 7.498941850e-03f, 6.978305988e-03f, 6.493816152e-03f, 6.042963825e-03f, 5.623413250e-03f, 5.232991185e-03f, 4.869675264e-03f, 4.531583283e-03f, 4.216964822e-03f, 3.924189601e-03f, 3.651741194e-03f, 3.398208413e-03f, 3.162277630e-03f, 2.942727180e-03f, 2.738419687e-03f, 2.548296936e-03f, 2.371373586e-03f, 2.206734149e-03f, 2.053524833e-03f, 1.910952968e-03f, 1.778279431e-03f, 1.654817141e-03f, 1.539926510e-03f, 1.433012541e-03f, 1.333521446e-03f, 1.240937738e-03f, 1.154781901e-03f, 1.074607833e-03f, 1.000000047e-03f, 9.305720450e-04f, 8.659643354e-04f, 8.058421663e-04f, 7.498942432e-04f, 6.978305755e-04f, 6.493816618e-04f, 6.042963942e-04f, 5.623413017e-04f, 5.232990952e-04f, 4.869675322e-04f, 4.531583691e-04f, 4.216965172e-04f, 3.924189659e-04f, 3.651741426e-04f, 3.398208355e-04f, 3.162277571e-04f, 2.942727006e-04f, 2.738419571e-04f, 2.548296761e-04f, 2.371373703e-04f, 2.206734061e-04f, 2.053525095e-04f, 1.910952997e-04f, 1.778279402e-04f, 1.654817170e-04f, 1.539926452e-04f, 1.433012512e-04f, 1.333521504e-04f, 1.240937709e-04f, 1.154782003e-04f, 1.074607862e-04f};

constexpr size_t MiB = 1u << 20;
constexpr size_t WS_CTL = 0, CTL_ZERO_BYTES = 1 * MiB;
constexpr size_t WS_TAB = 1 * MiB;
constexpr size_t WS_WAO = 4 * MiB, WS_WRO = 12 * MiB, WS_WO = 44 * MiB, WS_WGU = 76 * MiB, WS_WD = 248 * MiB, WS_WPG = 334 * MiB, WS_WPU = 366 * MiB;
constexpr size_t WS_PB = 368 * MiB, WS_WIN = 376 * MiB, WS_XB = 608 * MiB;
constexpr size_t WS_QA = 736 * MiB, WS_KA = 832 * MiB, WS_VTG = 928 * MiB, WS_QR = 1024 * MiB, WS_KR = 1088 * MiB, WS_KPT = 1152 * MiB, WS_VTR = 1216 * MiB,
                 WS_GR = 1344 * MiB, WS_GA = 1472 * MiB, WS_GRT = 1600 * MiB;
constexpr size_t WS_ST = 376 * MiB, WS_OG = 632 * MiB, WS_LSE = 728 * MiB;
constexpr size_t WS_OATT = 736 * MiB, WS_RG = 768 * MiB;
constexpr size_t WS_MIX = 896 * MiB, WS_T = 1024 * MiB;
constexpr size_t WS_STAT = 1152 * MiB, WS_H1B = 1408 * MiB;
constexpr size_t WS_HID = 376 * MiB;
constexpr size_t WS_X8 = 1728 * MiB;
constexpr size_t WS_WG8 = 1792 * MiB;
constexpr size_t WS_END = 1824 * MiB;
static_assert(WS_OG + 96 * MiB <= WS_LSE && WS_LSE + 2 * MiB <= WS_QA && WS_RG + 128 * MiB <= WS_MIX && WS_T + 128 * MiB <= WS_STAT && WS_H1B + 128 * MiB <= WS_END && WS_HID + 344 * MiB <= WS_OATT && WS_GRT + 128 * MiB <= WS_X8 && WS_X8 + 64 * MiB <= WS_WG8 && WS_WG8 + 32 * MiB <= WS_END, "d_ws map");
constexpr int CW_TMO = 0, CW_WORK = 64;
constexpr int CW_BAR = 4096;

constexpr int RING_BYTES = 131072;
constexpr int LDSCTL_OFF = RING_BYTES, MISC_OFF = LDSCTL_OFF + 320;
constexpr int LDS_BYTES = 147456;
constexpr int NWAVES = 8;

__device__ __forceinline__ unsigned cvtpk(float lo, float hi) { f32x2_t v = {lo, hi}; bf16x2_t b = __builtin_convertvector(v, bf16x2_t); return __builtin_bit_cast(unsigned, b); }
__device__ __forceinline__ unsigned pk_fp8x4(float a, float b, float c, float d) { int w = __builtin_amdgcn_cvt_pk_fp8_f32(a, b, 0, false); w = __builtin_amdgcn_cvt_pk_fp8_f32(c, d, w, true); return (unsigned)w; }
__device__ __forceinline__ float bflo(unsigned w) { return __uint_as_float(w << 16); }
__device__ __forceinline__ float bfhi(unsigned w) { return __uint_as_float(w & 0xffff0000u); }
__device__ __forceinline__ float fexp2(float x) { return __builtin_amdgcn_exp2f(x); }
__device__ __forceinline__ float frcp(float x) { return __builtin_amdgcn_rcpf(x); }
__device__ __forceinline__ float sigmoidf_(float x) { return frcp(1.0f + fexp2(-1.4426950408889634f * x)); }
__device__ __forceinline__ float siluf_(float x) { return x * sigmoidf_(x); }
__device__ __forceinline__ void sincos_pos(float a, float& s, float& c) {
    const float k = rintf(a * 0.15915494309189535f);
    float r = fmaf(-k, 6.28125f, a);
    r = fmaf(-k, 1.935307179586232e-3f, r);
    const float rv = r * 0.15915494309189535f;
    s = __builtin_amdgcn_sinf(rv); c = __builtin_amdgcn_cosf(rv);
}
__device__ __forceinline__ int lane_now() { int l; asm volatile("v_mbcnt_lo_u32_b32 %0, -1, 0\n\tv_mbcnt_hi_u32_b32 %0, -1, %0" : "=v"(l)); return l; }
__device__ __forceinline__ float wave_sum(float v) {
#pragma unroll
    for (int o = 1; o < 64; o <<= 1) v += __shfl_xor(v, o);
    return v;
}

#define XB_TMO      128
#define XB_XCNT(j)  (256  + 64 * (j))
#define XB_XSUB(j)  (1280 + 64 * (j))
#define XB_XGEN(j)  (2304 + 64 * (j))
#define XB_TOP      3328
#define XB_TOPGEN   3392
#define XCD_BAR_WORDS 3456
#define XB_SPIN_CAP (1u << 18)
__device__ __forceinline__ unsigned xb_ld(unsigned* p)              { return __hip_atomic_load(p, __ATOMIC_RELAXED, __HIP_MEMORY_SCOPE_AGENT); }
__device__ __forceinline__ unsigned xb_add(unsigned* p, unsigned v) { return __hip_atomic_fetch_add(p, v, __ATOMIC_RELAXED, __HIP_MEMORY_SCOPE_AGENT); }
__device__ __forceinline__ unsigned xb_xcc_id() { return (unsigned)__builtin_amdgcn_s_getreg((3 << 11) | 20) & 0xFu; }
#define XB_SPIN(cond, bar) do { unsigned _sp = 0; while (cond) { __builtin_amdgcn_s_sleep(1); \
    if ((++_sp & 255u) == 0u) { if (xb_ld(&(bar)[XB_TMO])) break; if (_sp > XB_SPIN_CAP) { atomicAdd(&(bar)[XB_TMO], 1u); break; } } } } while (0)
struct XcdBarrier { unsigned* bar; unsigned x; volatile LAS unsigned* st; int wave; };
__device__ __forceinline__ XcdBarrier xcd_barrier_post(unsigned* bar, volatile LAS unsigned* st, int wave) {
    XcdBarrier b; b.bar = bar; b.x = xb_xcc_id(); b.st = st; b.wave = wave;
    if (wave == 0 && lane_now() == 0) (void)xb_add(&bar[XB_XCNT(b.x)], 1u);
    return b;
}
__device__ __forceinline__ void xcd_barrier_complete(unsigned* bar, unsigned x, unsigned& nloc, unsigned& nx) {
    const unsigned G = gridDim.x * gridDim.y * gridDim.z;
    unsigned sum, cnt, mine, sp = 0u;
    for (;;) {
        sum = 0u; cnt = 0u; mine = 0u;
#pragma unroll
        for (unsigned j = 0; j < 16; ++j) { const unsigned c = xb_ld(&bar[XB_XCNT(j)]); sum += c; cnt += (c > 0u) ? 1u : 0u; mine = (j == x) ? c : mine; }
        if (sum == G) break;
        __builtin_amdgcn_s_sleep(1);
        if ((++sp & 255u) == 0u) { if (xb_ld(&bar[XB_TMO])) break; if (sp > XB_SPIN_CAP) { atomicAdd(&bar[XB_TMO], 1u); break; } }
    }
    nloc = mine > 0u ? mine : 1u; nx = cnt > 0u ? cnt : 1u;
}
__device__ __forceinline__ void xcd_barrier(const XcdBarrier& b) {
    asm volatile("s_waitcnt vmcnt(0)" ::: "memory");
    __syncthreads();
    if (b.wave == 0 && lane_now() == 0) {
        unsigned* bar = b.bar;
        __builtin_amdgcn_s_waitcnt(0);
        unsigned nloc = b.st[0], nx = b.st[1];
        if (nloc == 0u) { xcd_barrier_complete(bar, b.x, nloc, nx); b.st[0] = nloc; b.st[1] = nx; }
        const unsigned old = xb_add(&bar[XB_XSUB(b.x)], 1u);
        const unsigned gen = old / nloc;
        if (old + 1u == (gen + 1u) * nloc) {
            __builtin_amdgcn_fence(__ATOMIC_RELEASE, "agent");
            asm volatile("s_waitcnt vmcnt(0)" ::: "memory");
            const unsigned og = xb_add(&bar[XB_TOP], 1u);
            const unsigned tg = og / nx;
            if (og + 1u == (tg + 1u) * nx) xb_add(&bar[XB_TOPGEN], 1u);
            else XB_SPIN(xb_ld(&bar[XB_TOPGEN]) == tg, bar);
            __builtin_amdgcn_fence(__ATOMIC_ACQUIRE, "agent");
            xb_add(&bar[XB_XGEN(b.x)], 1u);
            asm volatile("s_waitcnt vmcnt(0)" ::: "memory");
        } else {
            XB_SPIN(xb_ld(&bar[XB_XGEN(b.x)]) == gen, bar);
            __builtin_amdgcn_fence(__ATOMIC_ACQUIRE, "agent");
            asm volatile("s_waitcnt vmcnt(0)" ::: "memory");
        }
    }
    __syncthreads();
}

namespace ge {
constexpr int BM = 256, BK = 64, HALF = 128, HTB = HALF * BK * 2, STAGE_BYTES = 8 * HTB;
__host__ __device__ __forceinline__ int lds_byte(int r, int c) { const int st = (r >> 4) * 2 + (c >> 5), rr = r & 15, cc = c & 31, ob = rr * 64 + cc * 2; return st * 1024 + (ob ^ (((ob >> 9) & 1) << 5)); }
__host__ __device__ __forceinline__ void stage_rc(int b, int& R, int& C) { const int st = b / 1024, sb = b % 1024, swz = sb ^ (((sb >> 9) & 1) << 5); R = (st >> 1) * 16 + swz / 64; C = (st & 1) * 32 + (swz % 64) / 2; }
__host__ __device__ __forceinline__ int perm32(int rho) { const int n = rho >> 4, i = rho & 15; return 8 * (i >> 2) + 4 * n + (i & 3); }

enum Kind { K_SCALE = 0, K_ROT = 1, K_ROTT = 2, K_SILU = 3, K_SIG = 4, K_MID = 5, K_FIN = 6, K_WO = 7, K_SWIGLU = 8, K_PLE = 9, K_DOWN = 10 };
struct GU {
    const char* A; const char* B;
    char* out;
    const char* x0; const char* x1;
    unsigned sA, sB;
    int nt;
    unsigned ldo, ldx;
    int i0, i1;
    int pad[3];
};
static_assert(sizeof(GU) == 80, "unit table entry");
constexpr int GU_DW = 20;
__device__ __forceinline__ void tile_of(int local, int nM, int nN, int& pm, int& pn) {
    const int nwg = nM * nN; int wgid = local;
    { const int q = nwg / 8, r = nwg % 8, xcd = wgid % 8, off = wgid / 8; wgid = (xcd < r ? xcd * (q + 1) : r * (q + 1) + (xcd - r) * q) + off; }
    const int nig = 8 * nN, gid = wgid / nig, fm = gid * 8, gsz = (nM - fm) < 8 ? (nM - fm) : 8;
    pm = fm + ((wgid % nig) % gsz); pn = (wgid % nig) / gsz;
}

typedef f32x4 Acc[2][2][4][2];
#define EPI_FENCE() do { asm volatile("" ::: "memory"); __builtin_amdgcn_sched_barrier(0); } while (0)
__device__ __forceinline__ u32x4 pack8(const f32x4 a, const f32x4 b) { u32x4 w; w.x = cvtpk(a[0], a[1]); w.y = cvtpk(a[2], a[3]); w.z = cvtpk(b[0], b[1]); w.w = cvtpk(b[2], b[3]); return w; }
__device__ __forceinline__ void unpack8(const u32x4 w, f32x4& a, f32x4& b) { a = (f32x4){bflo(w.x), bfhi(w.x), bflo(w.y), bfhi(w.y)}; b = (f32x4){bflo(w.z), bfhi(w.z), bflo(w.w), bfhi(w.w)}; }

template <int MODE>
__device__ __forceinline__ void epi_bf16(Acc& acc, const GU& u, int r0, int c0) {
    const float f = __int_as_float(u.i0);
#pragma unroll
    for (int ai = 0; ai < 2; ++ai)
#pragma unroll
        for (int m = 0; m < 4; ++m) { EPI_FENCE(); char* rowp = u.out + (size_t)(r0 + ai * 128 + m * 16) * u.ldo + (size_t)c0 * 2;
#pragma unroll
            for (int bj = 0; bj < 2; ++bj) { const f32x4 a0 = acc[ai][bj][m][0], a1 = acc[ai][bj][m][1]; f32x4 v0, v1;
                if (MODE == 0) { v0 = a0 * f; v1 = a1 * f; }
                else if (MODE == 1) { v0 = (f32x4){siluf_(a0[0] * f), siluf_(a0[1] * f), siluf_(a0[2] * f), siluf_(a0[3] * f)}; v1 = (f32x4){siluf_(a1[0] * f), siluf_(a1[1] * f), siluf_(a1[2] * f), siluf_(a1[3] * f)}; }
                else { v0 = (f32x4){sigmoidf_(a0[0] * f), sigmoidf_(a0[1] * f), sigmoidf_(a0[2] * f), sigmoidf_(a0[3] * f)}; v1 = (f32x4){sigmoidf_(a1[0] * f), sigmoidf_(a1[1] * f), sigmoidf_(a1[2] * f), sigmoidf_(a1[3] * f)}; }
                *(GAS u32x4*)(rowp + bj * 256) = pack8(v0, v1); } }
}
__device__ __forceinline__ void mid_scale(Acc& acc, const GU& u, int wr, int wc) {
    const int ln = lane_now(), r0 = wr * 64 + (ln & 15), c0 = wc * 32 + 8 * (ln >> 4);
#pragma unroll
    for (int ai = 0; ai < 2; ++ai)
#pragma unroll
        for (int mp = 0; mp < 2; ++mp) { EPI_FENCE(); u32x4 wa[2][2], wg[2][2];
#pragma unroll
            for (int mm = 0; mm < 2; ++mm) { const size_t ro = (size_t)(r0 + ai * 128 + (2 * mp + mm) * 16) * u.ldx + (size_t)c0 * 2;
#pragma unroll
                for (int bj = 0; bj < 2; ++bj) { wa[mm][bj] = *(const GAS u32x4*)(u.x0 + ro + bj * 256); wg[mm][bj] = *(const GAS u32x4*)(u.x1 + ro + bj * 256); } }
#pragma unroll
            for (int mm = 0; mm < 2; ++mm)
#pragma unroll
                for (int bj = 0; bj < 2; ++bj) { const int m = 2 * mp + mm; f32x4 a0, a1, g0, g1; unpack8(wa[mm][bj], a0, a1); unpack8(wg[mm][bj], g0, g1);
#pragma unroll
                    for (int t = 0; t < 4; ++t) { acc[ai][bj][m][0][t] *= a0[t] * frcp(g0[t]); acc[ai][bj][m][1][t] *= a1[t] * frcp(g1[t]); } } }
}
#define KM(k) (KIND == (k))
template <int KIND>
__device__ __forceinline__ void epilogue(Acc& acc, const GU& u, int wr, int wc) {
    const int ln = lane_now(), r0 = wr * 64 + (ln & 15), c0 = wc * 32 + 8 * (ln >> 4);
    switch (KIND) {
    case K_SCALE: if constexpr (KM(K_SCALE)) { epi_bf16<0>(acc, u, r0, c0); } break;
    case K_SILU: if constexpr (KM(K_SILU)) { epi_bf16<1>(acc, u, r0, c0); } break;
    case K_SIG: if constexpr (KM(K_SIG)) { epi_bf16<2>(acc, u, r0, c0); } break;
    case K_ROT: if constexpr (KM(K_ROT)) {
        const float f = __int_as_float(u.i1);
        float invf[8];
#pragma unroll
        for (int j = 0; j < 8; ++j) invf[j] = INVF[c0 + j];
#pragma unroll
        for (int ai = 0; ai < 2; ++ai)
#pragma unroll
            for (int m = 0; m < 4; ++m) { EPI_FENCE(); const int row = r0 + ai * 128 + m * 16; const float pos = (float)((u.i0 + row) & (SEQ - 1));
                char* rowp = u.out + (size_t)row * u.ldo + (size_t)c0 * 2; f32x4 o1[2], o2[2];
#pragma unroll
                for (int n = 0; n < 2; ++n)
#pragma unroll
                    for (int t = 0; t < 4; ++t) { float s, c; sincos_pos(pos * invf[4 * n + t], s, c); const float t1 = acc[ai][0][m][n][t], t2 = acc[ai][1][m][n][t];
                        o1[n][t] = (t1 * c - t2 * s) * f; o2[n][t] = (t1 * s + t2 * c) * f; }
                *(GAS u32x4*)(rowp) = pack8(o1[0], o1[1]); *(GAS u32x4*)(rowp + 256) = pack8(o2[0], o2[1]); }
    } break;
    case K_ROTT: if constexpr (KM(K_ROTT)) {
        const float lg = LOG2G[u.i1]; float dec[8];
#pragma unroll
        for (int j = 0; j < 8; ++j) dec[j] = 0.0625f * fexp2((float)(127 - (c0 + j)) * lg);
#pragma unroll
        for (int m = 0; m < 4; ++m) { const int row = r0 + m * 16; const float iv = INVF[row];
#pragma unroll
            for (int bj = 0; bj < 2; ++bj) { EPI_FENCE(); f32x4 o1[2], o2[2];
#pragma unroll
                for (int n = 0; n < 2; ++n)
#pragma unroll
                    for (int t = 0; t < 4; ++t) { const float pos = (float)((u.i0 + bj * 128 + c0 + 4 * n + t) & (SEQ - 1)); float s, c; sincos_pos(pos * iv, s, c);
                        const float t1 = acc[0][bj][m][n][t], t2 = acc[1][bj][m][n][t], d = dec[4 * n + t];
                        o1[n][t] = (t1 * c - t2 * s) * d; o2[n][t] = (t1 * s + t2 * c) * d; }
                char* p1 = u.out + (size_t)row * u.ldo + (size_t)(bj * 128 + c0) * 2;
                *(GAS u32x4*)(p1) = pack8(o1[0], o1[1]); *(GAS u32x4*)(p1 + (size_t)128 * u.ldo) = pack8(o2[0], o2[1]); } }
    } break;
    case K_FIN: if constexpr (KM(K_FIN)) {
#pragma unroll
        for (int ai = 0; ai < 2; ++ai) { EPI_FENCE(); u32x4 wg[4][2];
#pragma unroll
            for (int m = 0; m < 4; ++m) { const size_t ro = (size_t)(r0 + ai * 128 + m * 16) * u.ldx + (size_t)c0 * 2;
#pragma unroll
                for (int bj = 0; bj < 2; ++bj) wg[m][bj] = *(const GAS u32x4*)(u.x1 + ro + bj * 256); }
#pragma unroll
            for (int m = 0; m < 4; ++m) { char* rowp = u.out + (size_t)(r0 + ai * 128 + m * 16) * u.ldo + (size_t)c0 * 2;
#pragma unroll
                for (int bj = 0; bj < 2; ++bj) { f32x4 g0, g1; unpack8(wg[m][bj], g0, g1);
                    *(GAS u32x4*)(rowp + bj * 256) = pack8(acc[ai][bj][m][0] * g0, acc[ai][bj][m][1] * g1); } } }
    } break;
    case K_WO: if constexpr (KM(K_WO)) {
        const float f = __int_as_float(u.i0);
#pragma unroll
        for (int ai = 0; ai < 2; ++ai)
#pragma unroll
            for (int mp = 0; mp < 2; ++mp) { EPI_FENCE(); f32x4 xv[2][2][2];
#pragma unroll
                for (int mm = 0; mm < 2; ++mm) { const size_t xo = (size_t)(r0 + ai * 128 + (2 * mp + mm) * 16) * u.ldx + (size_t)c0 * 4;
#pragma unroll
                    for (int bj = 0; bj < 2; ++bj) { xv[mm][bj][0] = *(const GAS f32x4*)(u.x0 + xo + bj * 512); xv[mm][bj][1] = *(const GAS f32x4*)(u.x0 + xo + bj * 512 + 16); } }
#pragma unroll
                for (int mm = 0; mm < 2; ++mm) { const int m = 2 * mp + mm; char* rowp = u.out + (size_t)(r0 + ai * 128 + m * 16) * u.ldo + (size_t)c0 * 4;
#pragma unroll
                    for (int bj = 0; bj < 2; ++bj) { *(GAS f32x4*)(rowp + bj * 512) = xv[mm][bj][0] * f + acc[ai][bj][m][0]; *(GAS f32x4*)(rowp + bj * 512 + 16) = xv[mm][bj][1] * f + acc[ai][bj][m][1]; } } }
    } break;
    case K_SWIGLU: if constexpr (KM(K_SWIGLU)) {
#pragma unroll
        for (int ai = 0; ai < 2; ++ai)
#pragma unroll
            for (int m = 0; m < 4; ++m) { EPI_FENCE(); char* rowp = u.out + (size_t)(r0 + ai * 128 + m * 16) * u.ldo + (size_t)c0 * 2; f32x4 h0, h1;
#pragma unroll
                for (int t = 0; t < 4; ++t) { h0[t] = siluf_(acc[ai][0][m][0][t]) * acc[ai][1][m][0][t]; h1[t] = siluf_(acc[ai][0][m][1][t]) * acc[ai][1][m][1][t]; }
                *(GAS u32x4*)(rowp) = pack8(h0, h1); }
    } break;
    case K_PLE: if constexpr (KM(K_PLE)) {
#pragma unroll
        for (int ai = 0; ai < 2; ++ai) { EPI_FENCE(); u32x4 wt[4][2];
#pragma unroll
            for (int m = 0; m < 4; ++m) { const size_t to = (size_t)(r0 + ai * 128 + m * 16) * u.ldx + (size_t)c0 * 2;
#pragma unroll
                for (int bj = 0; bj < 2; ++bj) wt[m][bj] = *(const GAS u32x4*)(u.x0 + to + bj * 256); }
#pragma unroll
            for (int m = 0; m < 4; ++m) { char* rowp = u.out + (size_t)(r0 + ai * 128 + m * 16) * u.ldo + (size_t)c0 * 2;
#pragma unroll
                for (int bj = 0; bj < 2; ++bj) { f32x4 t0, t1; unpack8(wt[m][bj], t0, t1); const f32x4 a0 = acc[ai][bj][m][0], a1 = acc[ai][bj][m][1];
                    const f32x4 o0 = {sigmoidf_(a0[0]) * t0[0], sigmoidf_(a0[1]) * t0[1], sigmoidf_(a0[2]) * t0[2], sigmoidf_(a0[3]) * t0[3]};
                    const f32x4 o1 = {sigmoidf_(a1[0]) * t1[0], sigmoidf_(a1[1]) * t1[1], sigmoidf_(a1[2]) * t1[2], sigmoidf_(a1[3]) * t1[3]};
                    *(GAS u32x4*)(rowp + bj * 256) = pack8(o0, o1); } } }
    } break;
    case K_DOWN: if constexpr (KM(K_DOWN)) {
        const GAS f32x2_t* stat = (const GAS f32x2_t*)u.x0 + u.i0; const GAS f32x4* gb = (const GAS f32x4*)((const GAS f32x2_t*)u.x0 + M + u.i1 + c0);
        f32x4 gbv[2][4];
#pragma unroll
        for (int bj = 0; bj < 2; ++bj)
#pragma unroll
            for (int j = 0; j < 4; ++j) gbv[bj][j] = gb[bj * 64 + j];
#pragma unroll
        for (int ai = 0; ai < 2; ++ai)
#pragma unroll
            for (int mp = 0; mp < 2; ++mp) { EPI_FENCE(); f32x4 xv[2][2][2]; u32x4 pl[2][2]; f32x2_t st[2];
#pragma unroll
                for (int mm = 0; mm < 2; ++mm) { const int row = r0 + ai * 128 + (2 * mp + mm) * 16; const char* xp = u.out + (size_t)row * u.ldo + (size_t)c0 * 4; const size_t po = (size_t)row * u.ldx + (size_t)c0 * 2; st[mm] = stat[row];
#pragma unroll
                    for (int bj = 0; bj < 2; ++bj) { xv[mm][bj][0] = *(const GAS f32x4*)(xp + bj * 512); xv[mm][bj][1] = *(const GAS f32x4*)(xp + bj * 512 + 16); pl[mm][bj] = *(const GAS u32x4*)(u.x1 + po + bj * 256); } }
#pragma unroll
                for (int mm = 0; mm < 2; ++mm) { const int m = 2 * mp + mm; char* rowp = u.out + (size_t)(r0 + ai * 128 + m * 16) * u.ldo + (size_t)c0 * 4; const float mu = st[mm][0], rs = st[mm][1];
#pragma unroll
                    for (int bj = 0; bj < 2; ++bj) { f32x4 p0, p1; unpack8(pl[mm][bj], p0, p1); const f32x4 x0 = xv[mm][bj][0], x1 = xv[mm][bj][1], a0 = acc[ai][bj][m][0], a1 = acc[ai][bj][m][1];
                        const f32x4 g01 = gbv[bj][0], g23 = gbv[bj][1], g45 = gbv[bj][2], g67 = gbv[bj][3];
                        const f32x4 o0 = {(x0[0] - mu) * rs * g01[0] + g01[1] + p0[0] + a0[0], (x0[1] - mu) * rs * g01[2] + g01[3] + p0[1] + a0[1], (x0[2] - mu) * rs * g23[0] + g23[1] + p0[2] + a0[2], (x0[3] - mu) * rs * g23[2] + g23[3] + p0[3] + a0[3]};
                        const f32x4 o1 = {(x1[0] - mu) * rs * g45[0] + g45[1] + p1[0] + a1[0], (x1[1] - mu) * rs * g45[2] + g45[3] + p1[1] + a1[1], (x1[2] - mu) * rs * g67[0] + g67[1] + p1[2] + a1[2], (x1[3] - mu) * rs * g67[2] + g67[3] + p1[3] + a1[3]};
                        *(GAS f32x4*)(rowp + bj * 512) = o0; *(GAS f32x4*)(rowp + bj * 512 + 16) = o1; } } }
    } break;
    default: break;
    }
}

#define CAS __attribute__((address_space(4)))
__device__ __forceinline__ bool fetch_unit(const unsigned* tab, int i, int count, GU& u) {
    if (i >= count) return false;
    const CAS unsigned long long* e8 = (const CAS unsigned long long*)(const CAS void*)(tab + (size_t)i * GU_DW);
    const CAS unsigned* e4 = (const CAS unsigned*)e8;
    u.A = (const char*)e8[0]; u.B = (const char*)e8[1]; u.out = (char*)e8[2]; u.x0 = (const char*)e8[3]; u.x1 = (const char*)e8[4];
    u.sA = e4[10]; u.sB = e4[11]; u.nt = (int)e4[12]; u.ldo = e4[13]; u.ldx = e4[14]; u.i0 = (int)e4[15]; u.i1 = (int)e4[16];
    return u.nt != 0;
}
template <int KIND, int CHAIN, bool FP8 = false, bool ALT = false>
__device__ __forceinline__ void gemm_stream(LAS unsigned char* lds, const unsigned* tab, int count, int wid) {
    const int wr = wid >> 2, wc = wid & 3;
    int aoff, boff; { const int lane = lane_now(), fr = lane & 15, fq = lane >> 4; aoff = lds_byte(wr * 64 + fr, fq * 8); boff = lds_byte(wc * 32 + fr, fq * 8); }
#define GE_LANE_RC(rA0, rB0, cc0) unsigned rA0, rB0, cc0; { const int _t = wid * 64 + lane_now(); int R, C; stage_rc(_t * 16, R, C); rA0 = (unsigned)R; rB0 = (unsigned)((R & ~31) + perm32(R & 31)); cc0 = (unsigned)C * 2u; }
    const unsigned ldsw = (unsigned)wid * 1024u;
    const unsigned ldsbase = (unsigned)__builtin_amdgcn_readfirstlane((int)((unsigned)(size_t)lds + ldsw));
#define GE_SA(b, h) (((b) * 2 + (h)) * HTB)
#define GE_SB(b, h) ((4 + (b) * 2 + (h)) * HTB)
#define GE_DMA(sbase, voff, ldsaddr) do { unsigned _keep; asm volatile("s_mov_b32 %0, m0\n\ts_mov_b32 m0, %3\n\ts_nop 0\n\tglobal_load_lds_dwordx4 %1, %2\n\ts_mov_b32 m0, %0" \
        : "=&s"(_keep) : "v"(voff), "s"(sbase), "s"(ldsaddr) : "memory"); } while (0)
#define GE_STAGE(bufoff, gbase, voff, s64) do { const char* _b0 = (const char*)(gbase); const char* _b1 = _b0 + (s64); \
        GE_DMA(_b0, (voff), ldsbase + (unsigned)(bufoff)); GE_DMA(_b1, (voff), ldsbase + (unsigned)(bufoff) + 8192u); } while (0)
#define GE_LDA(dst, b, h) do { _Pragma("unroll") for (int m = 0; m < 4; ++m) _Pragma("unroll") for (int k = 0; k < 2; ++k) dst[m][k] = *(const LAS bf16x8*)(lds + GE_SA(b, h) + aoff + m * 2048 + k * 1024); } while (0)
#define GE_LDB(dst, b, h) do { _Pragma("unroll") for (int n = 0; n < 2; ++n) _Pragma("unroll") for (int k = 0; k < 2; ++k) dst[n][k] = *(const LAS bf16x8*)(lds + GE_SB(b, h) + boff + n * 2048 + k * 1024); } while (0)
#define GE_MMA(ai, bj, At, Bt) do { __builtin_amdgcn_s_setprio(1); \
        if (FP8) { typedef int i4_t __attribute__((ext_vector_type(4))); typedef int i8_t __attribute__((ext_vector_type(8))); \
            _Pragma("unroll") for (int m = 0; m < 4; ++m) _Pragma("unroll") for (int n = 0; n < 2; ++n) { \
                const i8_t a8 = __builtin_shufflevector(__builtin_bit_cast(i4_t, At[m][0]), __builtin_bit_cast(i4_t, At[m][1]), 0, 1, 2, 3, 4, 5, 6, 7); \
                const i8_t b8 = __builtin_shufflevector(__builtin_bit_cast(i4_t, Bt[n][0]), __builtin_bit_cast(i4_t, Bt[n][1]), 0, 1, 2, 3, 4, 5, 6, 7); \
                acc[ai][bj][m][n] = __builtin_amdgcn_mfma_scale_f32_16x16x128_f8f6f4(b8, a8, acc[ai][bj][m][n], 0, 0, 0, 0x7F7F7F7F, 0, 0x79797979); \
                asm volatile("" : "+v"(acc[ai][bj][m][n])); } } \
        else { _Pragma("unroll") for (int m = 0; m < 4; ++m) _Pragma("unroll") for (int n = 0; n < 2; ++n) _Pragma("unroll") for (int k = 0; k < 2; ++k) \
            acc[ai][bj][m][n] = __builtin_amdgcn_mfma_f32_16x16x32_bf16(Bt[n][k], At[m][k], acc[ai][bj][m][n], 0, 0, 0); } \
        __builtin_amdgcn_s_setprio(0); } while (0)
#define GE_WAIT_V(n) asm volatile("s_waitcnt vmcnt(" #n ")" ::: "memory")
#define GE_WAIT_L(n) asm volatile("s_waitcnt lgkmcnt(" #n ")" ::: "memory")
#define GE_BAR __builtin_amdgcn_s_barrier()
#define GE_SCHED __builtin_amdgcn_sched_barrier(0)
#define GE_ZERO() do { _Pragma("unroll") for (int a = 0; a < 2; ++a) _Pragma("unroll") for (int b = 0; b < 2; ++b) _Pragma("unroll") for (int m = 0; m < 4; ++m) _Pragma("unroll") for (int n = 0; n < 2; ++n) acc[a][b][m][n] = (f32x4){0.f, 0.f, 0.f, 0.f}; } while (0)
#define GE_BODY(a1, a2, b2, a3, b3, v2A, v2B, h2A, h2B, q2A, q2B) do { \
            GE_LDB(B0, 0, 0); GE_LDB(B1, 0, 1); GE_SCHED; GE_LDA(At, 0, 0); GE_STAGE(GE_SA(1, 1), (a1) + chA, cvA, cqA); \
            GE_WAIT_V(8); GE_WAIT_L(0); GE_BAR; GE_MMA(0, 0, At, B0); GE_MMA(0, 1, At, B1); GE_BAR; GE_SCHED; \
            GE_LDA(At, 0, 1); GE_STAGE(GE_SB(0, 0), (b2), v2B, q2B); GE_STAGE(GE_SB(0, 1), (b2) + (h2B), v2B, q2B); GE_STAGE(GE_SA(0, 0), (a2), v2A, q2A); \
            GE_WAIT_V(8); GE_WAIT_L(0); GE_BAR; GE_MMA(1, 0, At, B0); GE_MMA(1, 1, At, B1); GE_BAR; GE_SCHED; \
            GE_LDB(B0, 1, 0); GE_LDB(B1, 1, 1); GE_SCHED; GE_LDA(At, 1, 0); GE_STAGE(GE_SA(0, 1), (a2) + (h2A), v2A, q2A); \
            GE_WAIT_V(8); GE_WAIT_L(0); GE_BAR; GE_MMA(0, 0, At, B0); GE_MMA(0, 1, At, B1); GE_BAR; GE_SCHED; \
            GE_LDA(At, 1, 1); GE_STAGE(GE_SB(1, 0), (b3), v2B, q2B); GE_STAGE(GE_SB(1, 1), (b3) + (h2B), v2B, q2B); GE_STAGE(GE_SA(1, 0), (a3), v2A, q2A); \
            GE_WAIT_V(8); GE_WAIT_L(0); GE_BAR; GE_MMA(1, 0, At, B0); GE_MMA(1, 1, At, B1); GE_BAR; GE_SCHED; } while (0)
    GU cur, nxt; int ui = 0;
    if (!fetch_unit(tab, 0, count, cur)) return;
    Acc acc; GE_ZERO();
    bf16x8 At[4][2], B0[2][2], B1[2][2];
    unsigned cvA, cvB; { GE_LANE_RC(rA0, rB0, cc0); cvA = rA0 * cur.sA + cc0; cvB = rB0 * cur.sB + cc0; }
    const char* cA = cur.A; const char* cB = cur.B; size_t chA = (size_t)128 * cur.sA, chB = (size_t)128 * cur.sB, cqA = (size_t)64 * cur.sA, cqB = (size_t)64 * cur.sB;
    ptrdiff_t kstep = ALT ? -128 : 128;
    GE_STAGE(GE_SB(0, 0), cB, cvB, cqB); GE_STAGE(GE_SB(0, 1), cB + chB, cvB, cqB); GE_STAGE(GE_SA(0, 0), cA, cvA, cqA); GE_STAGE(GE_SA(0, 1), cA + chA, cvA, cqA);
    if (wr == 1) GE_BAR;
    GE_WAIT_V(2); GE_BAR;
    GE_STAGE(GE_SB(1, 0), cB + kstep, cvB, cqB); GE_STAGE(GE_SA(1, 0), cA + kstep, cvA, cqA); GE_STAGE(GE_SB(1, 1), cB + chB + kstep, cvB, cqB);
    GE_WAIT_V(6); GE_BAR;
    for (;;) {
        const bool has_next = fetch_unit(tab, ui + 1, count, nxt);
        const int nt = cur.nt;
        for (int t = 0; t < nt - 2; t += 2) {
            const char* a1 = cA + (ptrdiff_t)(t + 1) * kstep; const char* a2 = cA + (ptrdiff_t)(t + 2) * kstep; const char* b2 = cB + (ptrdiff_t)(t + 2) * kstep;
            GE_BODY(a1, a2, b2, a2 + kstep, b2 + kstep, cvA, cvB, chA, chB, cqA, cqB);
        }
        {
            const char* nA = cA; const char* nB = cB; size_t nhA = chA, nhB = chB, nqA = cqA, nqB = cqB; unsigned nvA = cvA, nvB = cvB;
            if (has_next) { nA = nxt.A; nB = nxt.B; nhA = (size_t)128 * nxt.sA; nhB = (size_t)128 * nxt.sB; nqA = (size_t)64 * nxt.sA; nqB = (size_t)64 * nxt.sB; GE_LANE_RC(rA0, rB0, cc0); nvA = rA0 * nxt.sA + cc0; nvB = rB0 * nxt.sB + cc0; }
            const char* a1 = cA + (ptrdiff_t)(nt - 1) * kstep; const ptrdiff_t nks = ALT ? (has_next ? -kstep : kstep) : 128;
            GE_BODY(a1, nA, nB, nA + nks, nB + nks, nvA, nvB, nhA, nhB, nqA, nqB);
            if (wr == 0) GE_BAR;
            if (CHAIN == 1 && !(ui & 1)) { mid_scale(acc, cur, wr, wc); }
            else if (CHAIN == 2) { epilogue<KIND>(acc, cur, wr, wc); const float f = __int_as_float(cur.i1);
                _Pragma("unroll") for (int a = 0; a < 2; ++a) _Pragma("unroll") for (int b = 0; b < 2; ++b) _Pragma("unroll") for (int m = 0; m < 4; ++m) _Pragma("unroll") for (int n = 0; n < 2; ++n) { acc[a][b][m][n] = acc[a][b][m][n] * f; asm volatile("" : "+v"(acc[a][b][m][n])); } }
            else { epilogue<KIND>(acc, cur, wr, wc); if (has_next) GE_ZERO(); }
            if (!has_next) break;
            cur = nxt; cA = nA; cB = nB; chA = nhA; chB = nhB; cqA = nqA; cqB = nqB; cvA = nvA; cvB = nvB; if (ALT) kstep = -kstep;
            ++ui;
            if (wr == 1) GE_BAR;
        }
    }
    GE_WAIT_V(0);
    GE_BAR;
#undef GE_BODY
#undef GE_LANE_RC
#undef GE_SA
#undef GE_SB
#undef GE_STAGE
#undef GE_LDA
#undef GE_LDB
#undef GE_MMA
#undef GE_WAIT_V
#undef GE_WAIT_L
#undef GE_BAR
#undef GE_SCHED
#undef GE_ZERO
}
}

struct Args { const float* in[16]; float* out; unsigned char* ws; int ph_lo, ph_hi; };
struct Frame {
    LAS unsigned char* lds;
    gu32* ctl;
    int wave, G, c;
    unsigned char* ws;
};

__device__ __forceinline__ int perm_tile_token0(int g, int tile) {
    const int sh = 2 * g, L = SEQ >> sh, m0 = tile * 256, b = m0 >> 12, rem = m0 & (SEQ - 1), r = rem / L, j0 = rem % L;
    return (b << 12) + (j0 << sh) + r;
}

constexpr int SL_P1 = 0, SL_P1B = 13, SL_P1C = 17, SL_P1D = 19, SL_P1E = 23, SL_P3 = 31, SL_P3B = 35, SL_P4 = 43, SL_P5 = 47, SL_P5B = 69, SL_P6 = 74, SL_SCAN = 78, SL_G2 = 109, GX = 3, NSLOT = 109 + 2 * GX;
__device__ __forceinline__ void make_unit(int slot, int c, unsigned char* ws, const float* x, float* outp, ge::GU& u) {
    const char* xb = (const char*)(ws + WS_XB); const char* win = (const char*)(ws + WS_WIN);
    const unsigned rowK = D * 2;
    u.A = nullptr; u.B = nullptr; u.out = nullptr; u.x0 = nullptr; u.x1 = nullptr; u.sA = rowK; u.sB = rowK; u.nt = D / 64; u.ldo = 0; u.ldx = 0; u.i0 = __float_as_int(1.0f); u.i1 = 0; u.pad[0] = u.pad[1] = u.pad[2] = 0;
    if (slot >= SL_G2) {
        const int idx = c >> 3;
        if (c < 64 || (idx % 3) == 2) { u.nt = 0; return; }
        const int k = (idx - 8) - ((idx - 8) / 3 + 1), j = slot - SL_G2;
        c = ((2 * k + j / GX) << 3) | (c & 7); slot = SL_P1E + (8 - GX) + j % GX;
    }
    int pm, pn;
    const char* x8 = (const char*)(ws + WS_X8); const unsigned row8 = D;
    if (slot < 6) {
        const int isK = slot >= 3, g = isK ? slot - 3 : slot; ge::tile_of(c, 64, 4, pm, pn);
        u.A = x8 + (size_t)perm_tile_token0(g, pm) * row8; u.sA = row8 << (2 * g);
        u.B = win + (size_t)((isK ? 3072 : 0) + g * 1024 + pn * 256) * rowK; u.nt = D / 128;
        u.i0 = __float_as_int(isK ? 1.0f : QSCALE);
        u.out = (char*)ws + (isK ? WS_KA : WS_QA) + (size_t)g * ((size_t)M * 1024 * 2) + ((size_t)pm * 256 * 1024 + pn * 256) * 2; u.ldo = 1024 * 2;
    } else if (slot < 9) {
        const int g = slot - 6; ge::tile_of(c, 4, 64, pm, pn);
        u.A = win + (size_t)(6144 + g * 1024 + pm * 256) * rowK;
        u.B = x8 + (size_t)perm_tile_token0(g, pn) * row8; u.sB = row8 << (2 * g); u.nt = D / 128;
        u.out = (char*)ws + WS_VTG + (size_t)g * ((size_t)1024 * M * 2) + ((size_t)pm * 256 * M + pn * 256) * 2; u.ldo = M * 2;
    } else if (slot < 13) {
        ge::tile_of((slot - 9) * 256 + c, 16, 64, pm, pn);
        u.A = win + (size_t)(13312 + pm * 256) * rowK; u.B = xb + (size_t)pn * 256 * rowK;
        u.out = (char*)ws + WS_VTR + ((size_t)pm * 256 * M + pn * 256) * 2; u.ldo = M * 2;
    } else if (slot < 17) {
        const int isK = slot >= 15; ge::tile_of((slot - (isK ? 15 : 13)) * 256 + c, 64, 8, pm, pn);
        u.A = xb + (size_t)pm * 256 * rowK; u.B = win + (size_t)((isK ? 11264 : 9216) + pn * 256) * rowK;
        u.i0 = (pm * 256) & (SEQ - 1); u.i1 = __float_as_int(isK ? 0.0625f : 1.0f);
        u.out = (char*)ws + (isK ? WS_KR : WS_QR) + ((size_t)pm * 256 * 2048 + pn * 256) * 2; u.ldo = 2048 * 2;
    } else if (slot < 19) {
        ge::tile_of((slot - 17) * 256 + c, 8, 64, pm, pn);
        u.A = win + (size_t)(11264 + pm * 256) * rowK; u.B = xb + (size_t)pn * 256 * rowK;
        u.i0 = (pn * 256) & (SEQ - 1); u.i1 = pm;
        u.out = (char*)ws + WS_KPT + ((size_t)pm * 256 * M + pn * 256) * 2; u.ldo = M * 2;
    } else if (slot < 31) {
        const int sgm = (slot - 19) >> 2; ge::tile_of(((slot - 19) & 3) * 256 + c, 64, 16, pm, pn);
        u.A = xb + (size_t)pm * 256 * rowK; u.B = win + (size_t)(17408 + sgm * 4096 + pn * 256) * rowK;
        if (sgm != 0) { u.A = x8 + (size_t)pm * 256 * row8; u.sA = row8; u.nt = D / 128; u.B = (const char*)ws + WS_WG8 + (size_t)((sgm - 1) * 4096 + pn * 256) * row8; u.sB = row8; }
        u.out = (char*)ws + (sgm == 0 ? WS_GR : (sgm == 1 ? WS_GA : WS_GRT)) + ((size_t)pm * 256 * D + pn * 256) * 2; u.ldo = D * 2;
    } else if (slot < 35) {
        ge::tile_of((slot - 31) * 256 + c, 64, 16, pm, pn);
        u.A = (const char*)ws + WS_PB + (size_t)pm * 256 * PLE * 2; u.sA = PLE * 2; u.B = (const char*)ws + WS_WPU + (size_t)pn * 256 * PLE * 2; u.sB = PLE * 2; u.nt = PLE / 64;
        u.out = (char*)ws + WS_T + ((size_t)pm * 256 * D + pn * 256) * 2; u.ldo = D * 2;
    } else if (slot < 43) {
        const int j = slot - 35, part = j & 1; ge::tile_of((j >> 1) * 256 + c, 64, 16, pm, pn);
        const size_t go = ((size_t)pm * 256 * D + pn * 256) * 2;
        u.x0 = (const char*)ws + WS_GA + go; u.x1 = (const char*)ws + WS_GRT + go; u.ldx = D * 2; u.out = (char*)ws + WS_MIX + go; u.ldo = D * 2;
        if (part == 0) { u.A = (const char*)ws + WS_OATT + (size_t)pm * 256 * 1024 * 2; u.sA = 1024 * 2; u.B = (const char*)ws + WS_WAO + (size_t)pn * 256 * 1024 * 2; u.sB = 1024 * 2; u.nt = 1024 / 64; }
        else           { u.A = (const char*)ws + WS_RG + (size_t)pm * 256 * D * 2; u.B = (const char*)ws + WS_WRO + (size_t)pn * 256 * D * 2; }
    } else if (slot < 47) {
        ge::tile_of((slot - 43) * 256 + c, 64, 16, pm, pn);
        u.A = (const char*)ws + WS_MIX + (size_t)pm * 256 * D * 2; u.B = (const char*)ws + WS_WO + (size_t)pn * 256 * D * 2;
        u.i0 = __float_as_int(ALPHA); const size_t fo = ((size_t)pm * 256 * D + pn * 256) * 4;
        u.x0 = (const char*)x + fo; u.ldx = D * 4; u.out = (char*)outp + fo; u.ldo = D * 4;
    } else if (slot < 69) {
        const int L = (slot - 47) * 256 + c;
        if (L >= 64 * 86) { u.nt = 0; return; }
        ge::tile_of(L, 64, 86, pm, pn);
        u.A = (const char*)ws + WS_H1B + (size_t)pm * 256 * D * 2; u.B = (const char*)ws + WS_WGU + (size_t)pn * 256 * D * 2;
        u.out = (char*)ws + WS_HID + ((size_t)pm * 256 * FF + pn * 128) * 2; u.ldo = FF * 2;
    } else if (slot < 74) {
        const int j = slot - 69;
        if (j >= 3 && c < 128) { u.nt = 0; return; }
        ge::tile_of(j < 3 ? j * 256 + c : 768 + (j - 3) * 128 + (c - 128), 64, 16, pm, pn);
        u.A = x8 + (size_t)pm * 256 * row8; u.sA = row8; u.nt = D / 128; u.B = (const char*)ws + WS_WPG + (size_t)pn * 256 * D * 2;
        u.x0 = (const char*)ws + WS_T + ((size_t)pm * 256 * D + pn * 256) * 2; u.ldx = D * 2;
        u.out = (char*)ws + WS_T + ((size_t)pm * 256 * D + pn * 256) * 2; u.ldo = D * 2;
    } else if (slot < 78) {
        ge::tile_of((slot - 74) * 256 + c, 64, 16, pm, pn);
        u.A = (const char*)ws + WS_HID + (size_t)pm * 256 * FF * 2; u.sA = FF * 2; u.B = (const char*)ws + WS_WD + (size_t)pn * 256 * FF * 2; u.sB = FF * 2; u.nt = FF / 64;
        if (!((slot - 74) & 1)) { u.A += (size_t)(FF / 64 - 1) * 128; u.B += (size_t)(FF / 64 - 1) * 128; }
        u.i0 = pm * 256; u.i1 = pn * 256; const size_t fo = ((size_t)pm * 256 * D + pn * 256) * 4;
        u.x0 = (const char*)ws + WS_STAT; u.x1 = (const char*)ws + WS_T + fo / 2; u.ldx = D * 2; u.out = (char*)outp + fo; u.ldo = D * 4;
    } else {
        if (c >= 64) { u.nt = 0; return; }
        const int n = slot - 78, b = c >> 4, h = (c >> 1) & 7, eh = c & 1;
        u.A = (const char*)ws + WS_VTR + ((size_t)(h * 512 + eh * 256) * M + b * SEQ + n * 128) * 2; u.sA = M * 2;
        u.B = (const char*)ws + WS_KPT + ((size_t)(h * 256) * M + b * SEQ + n * 128) * 2; u.sB = M * 2; u.nt = 2;
        u.out = (char*)ws + WS_ST + ((size_t)((b * 8 + h) * 32 + n + 1) * 512 + eh * 256) * 256 * 2; u.ldo = 256 * 2;
        u.i0 = __float_as_int(1.0f); u.i1 = __float_as_int(exp2f(128.0f * LOG2G[h]));
    }
}

__device__ __forceinline__ void p0_transpose_item(const float* W, int K, int N, bf16* WT, int mode, LAS float* scr, int item, int lane) {
    const int nblk = N / 32, kb = item / nblk, nb = item % nblk, k0 = 64 * kb, n0 = 32 * nb;
    { f32x4 v[8]; const int c4 = 4 * (lane & 7);
#pragma unroll
      for (int i = 0; i < 8; ++i) v[i] = *(const GAS f32x4*)(W + (size_t)(k0 + 8 * i + (lane >> 3)) * N + n0 + c4);
#pragma unroll
      for (int i = 0; i < 8; ++i) { LAS float* d = scr + (8 * i + (lane >> 3)) * 33 + c4; d[0] = v[i][0]; d[1] = v[i][1]; d[2] = v[i][2]; d[3] = v[i][3]; } }
    LDS_WAIT(); asm volatile("" ::: "memory");
    const int c = lane & 7;
    const int nbase = (mode == 0 || mode >= 3) ? n0 : ((n0 >> 7) * 256 + (n0 & 127) + (mode == 2 ? 128 : 0));
#pragma unroll
    for (int j = 0; j < 4; ++j) { const int n = (lane >> 3) + 8 * j; const LAS float* s = scr + (8 * c) * 33 + n;
        if (mode >= 3) { u32x2 o8; o8.x = pk_fp8x4(64.f * s[0 * 33], 64.f * s[1 * 33], 64.f * s[2 * 33], 64.f * s[3 * 33]); o8.y = pk_fp8x4(64.f * s[4 * 33], 64.f * s[5 * 33], 64.f * s[6 * 33], 64.f * s[7 * 33]);
            *(GAS u32x2*)((char*)WT + (size_t)(nbase + n) * (mode == 3 ? K * 2 : K) + k0 + 8 * c) = o8; continue; }
        u32x4 o; o.x = cvtpk(s[0 * 33], s[1 * 33]); o.y = cvtpk(s[2 * 33], s[3 * 33]); o.z = cvtpk(s[4 * 33], s[5 * 33]); o.w = cvtpk(s[6 * 33], s[7 * 33]);
        *(GAS u32x4*)(WT + (size_t)(nbase + n) * K + k0 + 8 * c) = o; }
    LDS_WAIT(); asm volatile("" ::: "memory");
}
constexpr int I_IN = (D / 64) * (NIN / 32), I_AO = (1024 / 64) * (D / 32), I_SQ = (D / 64) * (D / 32), I_FF = (D / 64) * (FF / 32), I_DN = (FF / 64) * (D / 32), I_PU = (PLE / 64) * (D / 32);
constexpr int N_LATE = I_AO + 3 * I_SQ + 2 * I_FF + I_DN + I_PU;
__device__ __forceinline__ void late_weight_item(const Args& a, unsigned char* ws, LAS float* scr, int r, int lane) {
    if (r < I_AO) { p0_transpose_item(a.in[3], 1024, D, (bf16*)(ws + WS_WAO), 0, scr, r, lane); return; } r -= I_AO;
    if (r < I_SQ) { p0_transpose_item(a.in[4], D, D, (bf16*)(ws + WS_WRO), 0, scr, r, lane); return; } r -= I_SQ;
    if (r < I_SQ) { p0_transpose_item(a.in[6], D, D, (bf16*)(ws + WS_WO), 0, scr, r, lane); return; } r -= I_SQ;
    if (r < I_FF) { p0_transpose_item(a.in[9], D, FF, (bf16*)(ws + WS_WGU), 1, scr, r, lane); return; } r -= I_FF;
    if (r < I_FF) { p0_transpose_item(a.in[10], D, FF, (bf16*)(ws + WS_WGU), 2, scr, r, lane); return; } r -= I_FF;
    if (r < I_DN) { p0_transpose_item(a.in[11], FF, D, (bf16*)(ws + WS_WD), 0, scr, r, lane); return; } r -= I_DN;
    if (r < I_SQ) { p0_transpose_item(a.in[12], D, D, (bf16*)(ws + WS_WPG), 3, scr, r, lane); return; } r -= I_SQ;
    p0_transpose_item(a.in[13], PLE, D, (bf16*)(ws + WS_WPU), 0, scr, r, lane);
}
__device__ __forceinline__ void late_weights_queue(Frame& F, const Args& a, int cw) {
    LAS float* scr = (LAS float*)(F.lds + F.wave * 16384);
    unsigned cur = 0u, end = 0u;
    for (;;) {
        const int lane = lane_now();
        if (cur == end) { unsigned idx = 0;
            if (lane == 0) idx = __hip_atomic_fetch_add((unsigned*)(F.ctl + cw), 64u, RLX_AGENT);
            idx = (unsigned)__builtin_amdgcn_readfirstlane((int)idx);
            if (idx >= (unsigned)N_LATE) break;
            cur = idx; end = idx + 64u < (unsigned)N_LATE ? idx + 64u : (unsigned)N_LATE; }
        late_weight_item(a, F.ws, scr, (int)cur, lane); ++cur;
    }
}
__device__ __forceinline__ void p0_prologue(Frame& F, const Args& a) {
    const int lane = lane_now(), tid = F.wave * 64 + lane;
    if (tid < NSLOT) { ge::GU u; make_unit(tid, F.c, F.ws, a.in[0], a.out, u);
        GAS unsigned* dst = (GAS unsigned*)(F.ws + WS_TAB) + ((size_t)F.c * NSLOT + tid) * ge::GU_DW; const unsigned* src = (const unsigned*)&u;
#pragma unroll
        for (int k = 0; k < ge::GU_DW; ++k) dst[k] = src[k]; }
    LAS float* scr = (LAS float*)(F.lds + F.wave * 16384);
    const int gw = F.c * NWAVES + F.wave, NGW = F.G * NWAVES;
    unsigned char* ws = F.ws;
    for (int it = gw; it < I_IN; it += NGW) { const int n0 = 32 * (it % (NIN / 32));
        if (n0 >= 21504) p0_transpose_item(a.in[2], D, NIN, (bf16*)(ws + WS_WG8 - (size_t)21504 * D), 4, scr, it, lane);
        else p0_transpose_item(a.in[2], D, NIN, (bf16*)(ws + WS_WIN), n0 < 9216 ? 3 : 0, scr, it, lane); }
    const size_t gt = (size_t)F.c * 512 + tid, NT = (size_t)F.G * 512;
    { const GAS f32x4* src = (const GAS f32x4*)a.in[0]; GAS u32x4* dst = (GAS u32x4*)(ws + WS_XB);
      GAS u32x2* dst8 = (GAS u32x2*)(ws + WS_X8);
      for (size_t i = gt; i < (size_t)M * D / 8; i += NT) { const f32x4 v0 = src[2 * i], v1 = src[2 * i + 1]; dst[i] = ge::pack8(v0, v1);
          u32x2 w8; w8.x = pk_fp8x4(v0[0], v0[1], v0[2], v0[3]); w8.y = pk_fp8x4(v1[0], v1[1], v1[2], v1[3]); dst8[i] = w8; } }
    { const GAS f32x4* src = (const GAS f32x4*)a.in[1]; GAS u32x4* dst = (GAS u32x4*)(ws + WS_PB);
      for (size_t i = gt; i < (size_t)M * PLE / 8; i += NT) { const f32x4 v0 = src[2 * i], v1 = src[2 * i + 1]; dst[i] = ge::pack8(v0, v1); } }
}

#define MFMA32(a, b, c) __builtin_amdgcn_mfma_f32_32x32x16_bf16((a), (b), (c), 0, 0, 0)
__device__ __forceinline__ bf16x8 ldg8(const bf16* p) { return *(const GAS bf16x8*)p; }
__device__ __forceinline__ bf16x8 pack_frag(const f32x16& x, int s) {
    u32x4 p; p.x = cvtpk(x[8 * s + 0], x[8 * s + 1]); p.y = cvtpk(x[8 * s + 2], x[8 * s + 3]); p.z = cvtpk(x[8 * s + 4], x[8 * s + 5]); p.w = cvtpk(x[8 * s + 6], x[8 * s + 7]);
    return __builtin_bit_cast(bf16x8, p);
}
__device__ __forceinline__ f32x16 zero16() { f32x16 z;
#pragma unroll
    for (int i = 0; i < 16; ++i) z[i] = 0.f; return z; }

__device__ __forceinline__ void attn_wg_item(int item, unsigned char* ws, LAS unsigned char* lds, int w, int lane) {
    const int g = item >> 9, rem = item & 511, head = rem >> 6, qb = rem & 63;
    const int L = SEQ >> (2 * g), prow0 = qb * 256, q0 = prow0 & (L - 1), r32 = lane & 31, hh = lane >> 5;
    const bf16* Q = (const bf16*)(ws + WS_QA) + (size_t)g * M * 1024 + head * 128 + 8 * hh;
    const bf16* Kg = (const bf16*)(ws + WS_KA) + (size_t)g * M * 1024 + head * 128;
    const bf16* VTg = (const bf16*)(ws + WS_VTG) + (size_t)g * 1024 * M + (size_t)(head * 128) * M;
#define AW_ISSUE(p) do { LAS unsigned char* bufp_ = lds + ((p) & 1) * 65536; const int krow_ = prow0 - 128 + 128 * (p); _Pragma("unroll") for (int i_ = 0; i_ < 4; ++i_) { \
        const int row_ = 4 * (4 * w + i_) + (lane >> 4), pc_ = (lane & 15) ^ (row_ & 15); \
        __builtin_amdgcn_global_load_lds((const unsigned*)(Kg + (size_t)(krow_ + row_) * 1024 + pc_ * 8), (LAS unsigned*)(bufp_ + (4 * w + i_) * 1024), 16, 0, 0); \
        __builtin_amdgcn_global_load_lds((const unsigned*)(VTg + (size_t)row_ * M + krow_ + pc_ * 8), (LAS unsigned*)(bufp_ + 32768 + (4 * w + i_) * 1024), 16, 0, 0); } } while (0)
    const int p0 = q0 >= 128 ? 0 : 1;
    bf16x8 qf[8];
#pragma unroll
    for (int kb = 0; kb < 8; ++kb) qf[kb] = ldg8(Q + (size_t)(prow0 + 32 * w + r32) * 1024 + kb * 16);
    AW_ISSUE(p0);
    f32x16 o[4]; o[0] = zero16(); o[1] = zero16(); o[2] = zero16(); o[3] = zero16();
    float mrun = -1e30f, lrun = 0.f;
    const int kperm = (r32 & ~12) | ((r32 & 4) << 1) | ((r32 & 8) >> 1);
    for (int p = p0; p < 3; ++p) {
        VM_WAIT(); __syncthreads();
        if (p < 2) AW_ISSUE(p + 1);
        asm volatile("" ::: "memory"); __builtin_amdgcn_sched_barrier(0);
        const LAS unsigned char* kb_ = lds + (p & 1) * 65536; const LAS unsigned char* vb_ = kb_ + 32768;
        const int ch_lo = 4 * p > w ? 4 * p : w, ch_hi = 4 * p + 4 < w + 5 ? 4 * p + 4 : w + 5;
        for (int ch = ch_lo; ch < ch_hi; ++ch) {
            const int c = ch - w, cl = ch - 4 * p;
            if (q0 + 32 * w - 128 + 32 * c < 0) continue;
            bf16x8 kf[8];
            { const int krow = cl * 32 + kperm; const LAS unsigned char* kr = kb_ + krow * 256; const int kx = krow & 15;
#pragma unroll
              for (int kb = 0; kb < 8; ++kb) kf[kb] = *(const LAS bf16x8*)(kr + (((2 * kb + hh) ^ kx) << 4)); }
            f32x16 sa = zero16();
#pragma unroll
            for (int kb = 0; kb < 8; ++kb) sa = MFMA32(kf[kb], qf[kb], sa);
            float cm = -1e30f;
#pragma unroll
            for (int i = 0; i < 16; ++i) { const int kap = (i & 7) + 8 * hh + 16 * (i >> 3);
                const bool valid = !((c == 0 && kap < r32) || (c == 4 && kap > r32));
                sa[i] = valid ? sa[i] : -1e30f; cm = fmaxf(cm, sa[i]); }
            cm = fmaxf(cm, __shfl_xor(cm, 32));
            const float mnew = fmaxf(mrun, cm), alpha = fexp2(mrun - mnew);
            float ps = 0.f;
#pragma unroll
            for (int i = 0; i < 16; ++i) { sa[i] = fexp2(sa[i] - mnew); ps += sa[i]; }
            ps += __shfl_xor(ps, 32);
            lrun = lrun * alpha + ps; mrun = mnew;
            const bf16x8 pf0 = pack_frag(sa, 0), pf1 = pack_frag(sa, 1);
            bf16x8 vf[4][2];
#pragma unroll
            for (int eb = 0; eb < 4; ++eb)
#pragma unroll
                for (int s2 = 0; s2 < 2; ++s2) { const int row = eb * 32 + r32; vf[eb][s2] = *(const LAS bf16x8*)(vb_ + row * 256 + (((4 * cl + 2 * s2 + hh) ^ (row & 15)) << 4)); }
#pragma unroll
            for (int eb = 0; eb < 4; ++eb) { o[eb] = o[eb] * alpha; o[eb] = MFMA32(vf[eb][0], pf0, o[eb]); o[eb] = MFMA32(vf[eb][1], pf1, o[eb]); }
        }
    }
    __syncthreads();
    LAS unsigned char* wl = lds + 65536 + w * 8192;
    const float inv = 1.0f / lrun;
#pragma unroll
    for (int eb = 0; eb < 4; ++eb)
#pragma unroll
        for (int a = 0; a < 4; ++a) { u32x2 wv; wv.x = cvtpk(o[eb][4 * a] * inv, o[eb][4 * a + 1] * inv); wv.y = cvtpk(o[eb][4 * a + 2] * inv, o[eb][4 * a + 3] * inv);
            *(LAS u32x2*)(wl + r32 * 256 + (((eb * 4 + a) ^ (r32 & 15)) << 4) + 8 * hh) = wv; }
    LDS_WAIT();
    bf16* OG = (bf16*)(ws + WS_OG) + (size_t)g * M * 1024 + (size_t)(prow0 + 32 * w) * 1024 + head * 128;
#pragma unroll
    for (int j = 0; j < 8; ++j) { const int row = 4 * j + (lane >> 4), pc = (lane & 15) ^ (row & 15);
        const u32x4 v = *(const LAS u32x4*)(wl + row * 256 + ((lane & 15) << 4)); *(GAS u32x4*)(OG + (size_t)row * 1024 + pc * 8) = v; }
    if (hh == 0) ((GAS float*)(ws + WS_LSE))[(size_t)g * M * 8 + (size_t)(prow0 + 32 * w + r32) * 8 + head] = mrun + __builtin_amdgcn_logf(lrun);
    LDS_WAIT(); __syncthreads();
#undef AW_ISSUE
}
__device__ __forceinline__ void p2a_attention(Frame& F, int cw) {
    volatile LAS unsigned* slot = (volatile LAS unsigned*)(F.lds + MISC_OFF + 64);
    for (;;) {
        const int lane = lane_now();
        if (F.wave == 0 && lane == 0) *slot = __hip_atomic_fetch_add((unsigned*)(F.ctl + cw), 1u, RLX_AGENT);
        __syncthreads();
        const unsigned idx = (unsigned)__builtin_amdgcn_readfirstlane((int)*slot);
        __syncthreads();
        if (idx >= 1536u) break;
        attn_wg_item((int)idx, F.ws, F.lds, F.wave, lane);
    }
}

__device__ __forceinline__ void ret_unit(Frame& F, int unit, const float* gn_g) {
    const int b = unit >> 8, h = (unit >> 5) & 7, n = unit & 31, lane = lane_now(), w = F.wave, r32 = lane & 31, hh = lane >> 5;
    unsigned char* ws = F.ws;
    const int tok0 = b * SEQ + n * 128;
    const float lg = LOG2G[h];
    const bf16* QRg = (const bf16*)(ws + WS_QR) + (size_t)tok0 * 2048 + h * 256;
    const bf16* KR = (const bf16*)(ws + WS_KR) + (size_t)tok0 * 2048 + h * 256 + 8 * hh;
    LAS unsigned char* fr = F.lds;
    LAS float* stt = (LAS float*)(F.lds + 20480);
    LAS unsigned char* ql = F.lds + 32768;
    const int kperm = (r32 & ~12) | ((r32 & 4) << 1) | ((r32 & 8) >> 1);
#pragma unroll
    for (int i = 0; i < 8; ++i) { const int row = 2 * (w * 8 + i) + hh, pc = r32 ^ (row & 15);
        __builtin_amdgcn_global_load_lds((const unsigned*)(QRg + (size_t)row * 2048 + pc * 8), (LAS unsigned*)(ql + (w * 8 + i) * 1024), 16, 0, 0); }
    VM_WAIT(); __syncthreads();
#define RU_QFRAG(qb, ks) (*(const LAS bf16x8*)(ql + ((qb) * 32 + r32) * 512 + ((((2 * (ks) + hh)) ^ (r32 & 15)) << 4)))
    for (int k = w; k < 10; k += 8) {
        const int jb = k < 4 ? 0 : (k < 7 ? 1 : (k < 9 ? 2 : 3)), qb = k < 4 ? k : (k < 7 ? k - 3 : (k < 9 ? k - 5 : 3));
        f32x16 x = zero16();
        const bf16* ka = KR + (size_t)(jb * 32 + kperm) * 2048;
        bf16x8 kf[16];
#pragma unroll
        for (int ks = 0; ks < 16; ++ks) kf[ks] = ldg8(ka + ks * 16);
#pragma unroll
        for (int ks = 0; ks < 16; ++ks) x = MFMA32(kf[ks], RU_QFRAG(qb, ks), x);
#pragma unroll
        for (int i = 0; i < 16; ++i) { const int j = jb * 32 + (i & 7) + 8 * hh + 16 * (i >> 3), q = qb * 32 + r32, df = q - j; x[i] = df >= 0 ? x[i] * fexp2((float)df * lg) : 0.f; }
        *(LAS bf16x8*)(fr + ((k * 2 + 0) * 64 + lane) * 16) = pack_frag(x, 0);
        *(LAS bf16x8*)(fr + ((k * 2 + 1) * 64 + lane) * 16) = pack_frag(x, 1);
    }
    __syncthreads();
    f32x16 acc[2][4];
#pragma unroll
    for (int e2 = 0; e2 < 2; ++e2)
#pragma unroll
        for (int qb = 0; qb < 4; ++qb) acc[e2][qb] = zero16();
    if (n > 0) {
        const bf16* ST = (const bf16*)(ws + WS_ST) + ((size_t)(((b * 8 + h) * 32 + n)) * 512 + w * 64 + r32) * 256 + 8 * hh;
        bf16x8 sa[2][4][2];
#pragma unroll
        for (int j = 0; j < 4; ++j) { sa[0][j][0] = ldg8(ST + j * 16); sa[0][j][1] = ldg8(ST + (size_t)32 * 256 + j * 16); }
#pragma unroll
        for (int kb = 0; kb < 4; ++kb) {
            if (kb < 3) {
#pragma unroll
                for (int j = 0; j < 4; ++j) { sa[(kb + 1) & 1][j][0] = ldg8(ST + ((kb + 1) * 4 + j) * 16); sa[(kb + 1) & 1][j][1] = ldg8(ST + (size_t)32 * 256 + ((kb + 1) * 4 + j) * 16); } }
#pragma unroll
            for (int j = 0; j < 4; ++j) { const int ks = kb * 4 + j;
#pragma unroll
                for (int qb = 0; qb < 4; ++qb) { const bf16x8 bq = RU_QFRAG(qb, ks); acc[0][qb] = MFMA32(sa[kb & 1][j][0], bq, acc[0][qb]); acc[1][qb] = MFMA32(sa[kb & 1][j][1], bq, acc[1][qb]); } }
        }
#pragma unroll
        for (int qb = 0; qb < 4; ++qb) { const float sc = fexp2((float)(qb * 32 + r32 + 1) * lg); acc[0][qb] = acc[0][qb] * sc; acc[1][qb] = acc[1][qb] * sc; }
    }
    {
        const bf16* VT = (const bf16*)(ws + WS_VTR) + (size_t)(h * 512 + w * 64 + r32) * M + tok0 + 8 * hh;
#pragma unroll
        for (int jb = 0; jb < 4; ++jb)
#pragma unroll
            for (int s = 0; s < 2; ++s) {
                const bf16x8 a0 = ldg8(VT + jb * 32 + 16 * s), a1 = ldg8(VT + (size_t)32 * M + jb * 32 + 16 * s);
#pragma unroll
                for (int qb = jb; qb < 4; ++qb) { const int k = (jb == 0 ? 0 : (jb == 1 ? 4 : (jb == 2 ? 7 : 9))) + (qb - jb);
                    const bf16x8 p = *(const LAS bf16x8*)(fr + ((k * 2 + s) * 64 + lane) * 16);
                    acc[0][qb] = MFMA32(a0, p, acc[0][qb]); acc[1][qb] = MFMA32(a1, p, acc[1][qb]); }
            }
    }
#pragma unroll
    for (int qb = 0; qb < 4; ++qb) { float s1 = 0.f, s2 = 0.f;
#pragma unroll
        for (int e2 = 0; e2 < 2; ++e2)
#pragma unroll
            for (int i = 0; i < 16; ++i) { const float v = acc[e2][qb][i]; s1 += v; s2 += v * v; }
        s1 += __shfl_xor(s1, 32); s2 += __shfl_xor(s2, 32);
        if (hh == 0) { stt[((qb * 32 + r32) * 8 + w) * 2] = s1; stt[((qb * 32 + r32) * 8 + w) * 2 + 1] = s2; } }
    __syncthreads();
    const float* gp = gn_g + h * 512 + w * 64 + 4 * hh;
#pragma unroll
    for (int qb = 0; qb < 4; ++qb) { float s1 = 0.f, s2 = 0.f;
#pragma unroll
        for (int ww = 0; ww < 8; ++ww) { s1 += stt[((qb * 32 + r32) * 8 + ww) * 2]; s2 += stt[((qb * 32 + r32) * 8 + ww) * 2 + 1]; }
        const float mu = s1 * (1.0f / 512.0f), var = fmaxf(s2 * (1.0f / 512.0f) - mu * mu, 0.f), rstd = 1.0f / sqrtf(var + GN_EPS);
        const size_t ro = (size_t)(tok0 + qb * 32 + r32) * D + h * 512 + w * 64 + 4 * hh;
        const bf16* gr = (const bf16*)(ws + WS_GR) + ro; bf16* og = (bf16*)(ws + WS_RG) + ro;
#pragma unroll
        for (int e2 = 0; e2 < 2; ++e2)
#pragma unroll
            for (int a = 0; a < 4; ++a) { const f32x4 gg = *(const GAS f32x4*)(gp + e2 * 32 + 8 * a); const u32x2 sg = *(const GAS u32x2*)(gr + e2 * 32 + 8 * a);
                const float v0 = (acc[e2][qb][4 * a] - mu) * rstd * gg[0] * bflo(sg.x), v1 = (acc[e2][qb][4 * a + 1] - mu) * rstd * gg[1] * bfhi(sg.x);
                const float v2 = (acc[e2][qb][4 * a + 2] - mu) * rstd * gg[2] * bflo(sg.y), v3 = (acc[e2][qb][4 * a + 3] - mu) * rstd * gg[3] * bfhi(sg.y);
                u32x2 wv; wv.x = cvtpk(v0, v1); wv.y = cvtpk(v2, v3); *(GAS u32x2*)(og + e2 * 32 + 8 * a) = wv; } }
    __syncthreads();
}
#undef RU_QFRAG
__device__ __forceinline__ void combine_token(unsigned char* ws, int t, int lane) {
    const int b = t >> 12, sp = t & (SEQ - 1), head = lane >> 3;
    float lse[3]; size_t prow[3];
#pragma unroll
    for (int g = 0; g < 3; ++g) { const int sh = 2 * g, d = 1 << sh, L = SEQ >> sh; prow[g] = (size_t)(b * d + (sp & (d - 1))) * L + (sp >> sh);
        lse[g] = ((const GAS float*)(ws + WS_LSE))[(size_t)g * M * 8 + prow[g] * 8 + head]; }
    const float mx = fmaxf(lse[0], fmaxf(lse[1], lse[2]));
    float wg[3], ws_ = 0.f;
#pragma unroll
    for (int g = 0; g < 3; ++g) { wg[g] = fexp2(lse[g] - mx); ws_ += wg[g]; }
    const float inv = 1.0f / ws_;
    f32x4 o[4];
#pragma unroll
    for (int j = 0; j < 4; ++j) o[j] = (f32x4){0.f, 0.f, 0.f, 0.f};
#pragma unroll
    for (int g = 0; g < 3; ++g) { const bf16* og = (const bf16*)(ws + WS_OG) + (size_t)g * M * 1024 + prow[g] * 1024 + lane * 16;
        const u32x4 w0 = *(const GAS u32x4*)og, w1 = *(const GAS u32x4*)(og + 8); f32x4 a0, a1, a2, a3; ge::unpack8(w0, a0, a1); ge::unpack8(w1, a2, a3);
        const float f = wg[g] * inv; o[0] += a0 * f; o[1] += a1 * f; o[2] += a2 * f; o[3] += a3 * f; }
    bf16* oa = (bf16*)(ws + WS_OATT) + (size_t)t * 1024 + lane * 16;
    *(GAS u32x4*)oa = ge::pack8(o[0], o[1]); *(GAS u32x4*)(oa + 8) = ge::pack8(o[2], o[3]);
}
__device__ __forceinline__ void p2b_phase(Frame& F, const float* gn_g) {
    for (int u = F.c; u < 1024; u += F.G) ret_unit(F, u, gn_g);
    const int gw = F.c * NWAVES + F.wave, NGW = F.G * NWAVES;
    { const int lane = lane_now(); for (int t = gw; t < M; t += NGW) combine_token(F.ws, t, lane); }
}

template <int MODE>
__device__ __forceinline__ void ln_rows(Frame& F, const float* src, float* dstf, bf16* dstb, unsigned char* dst8, float* stat, const float* gam, const float* bet) {
    const int gw = F.c * NWAVES + F.wave, NGW = F.G * NWAVES, lane = lane_now();
    if (MODE == 1 && gw < D / 64) { const int col = gw * 64 + lane; ((GAS f32x2_t*)stat)[M + col] = (f32x2_t){ALPHA * gam[col], ALPHA * bet[col]}; }
    for (int m = gw; m < M; m += NGW) {
        const GAS f32x4* xr = (const GAS f32x4*)(src + (size_t)m * D) + lane;
        f32x4 v[16]; float s = 0.f;
#pragma unroll
        for (int j = 0; j < 16; ++j) { v[j] = xr[64 * j]; s += (v[j][0] + v[j][1]) + (v[j][2] + v[j][3]); }
        const float mean = wave_sum(s) * (1.0f / D); float s2 = 0.f;
#pragma unroll
        for (int j = 0; j < 16; ++j) { v[j] = v[j] - mean; s2 += (v[j][0] * v[j][0] + v[j][1] * v[j][1]) + (v[j][2] * v[j][2] + v[j][3] * v[j][3]); }
        const float rstd = 1.0f / sqrtf(wave_sum(s2) * (1.0f / D) + LN_EPS);
        if (MODE == 1 && lane == 0) ((GAS f32x2_t*)stat)[m] = (f32x2_t){mean, rstd};
        GAS f32x4* of = (GAS f32x4*)(dstf + (size_t)m * D) + lane;
        GAS u32x2* ob = (GAS u32x2*)(dstb + (size_t)m * D) + lane;
        GAS unsigned* o8 = (GAS unsigned*)(dst8 + (size_t)m * D) + lane;
#pragma unroll
        for (int j = 0; j < 16; ++j) { const f32x4 gg = *((const GAS f32x4*)gam + lane + 64 * j), bb = *((const GAS f32x4*)bet + lane + 64 * j);
            const f32x4 y = v[j] * rstd * gg + bb;
            if (MODE == 1) { u32x2 w; w.x = cvtpk(y[0], y[1]); w.y = cvtpk(y[2], y[3]); ob[64 * j] = w; o8[64 * j] = pk_fp8x4(y[0], y[1], y[2], y[3]); } else of[64 * j] = y; }
    }
}

__device__ __forceinline__ void kpt_transpose(Frame& F) {
    const int lane = lane_now(), gw = F.c * NWAVES + F.wave, NGW = F.G * NWAVES;
    LAS unsigned short* scr = (LAS unsigned short*)(F.lds + F.wave * 16384);
    const bf16* KR = (const bf16*)(F.ws + WS_KR); bf16* KT = (bf16*)(F.ws + WS_KPT);
    for (int it = gw; it < (M / 64) * (2048 / 64); it += NGW) {
        const int tb = it >> 5, fb = it & 31, tok0 = tb * 64, f0 = fb * 64, h = fb >> 2;
#pragma unroll
        for (int i = 0; i < 8; ++i) { const int r = 8 * i + (lane >> 3), cpos = (lane & 7) * 8;
            const u32x4 v = *(const GAS u32x4*)(KR + (size_t)(tok0 + r) * 2048 + f0 + cpos);
            LAS unsigned* d = (LAS unsigned*)(scr + r * 66 + cpos); d[0] = v.x; d[1] = v.y; d[2] = v.z; d[3] = v.w; }
        LDS_WAIT(); asm volatile("" ::: "memory");
        const float lg = LOG2G[h]; const int tpos = (lane & 7) * 8;
        float dec[8];
#pragma unroll
        for (int j = 0; j < 8; ++j) dec[j] = fexp2((float)(127 - ((tok0 + tpos + j) & 127)) * lg);
#pragma unroll
        for (int i = 0; i < 8; ++i) { const int f = 8 * i + (lane >> 3); float v[8];
#pragma unroll
            for (int j = 0; j < 8; ++j) v[j] = __uint_as_float((unsigned)scr[(tpos + j) * 66 + f] << 16) * dec[j];
            u32x4 o; o.x = cvtpk(v[0], v[1]); o.y = cvtpk(v[2], v[3]); o.z = cvtpk(v[4], v[5]); o.w = cvtpk(v[6], v[7]);
            *(GAS u32x4*)(KT + (size_t)(f0 + f) * M + tok0 + tpos) = o; }
        LDS_WAIT(); asm volatile("" ::: "memory");
    }
}

__global__ void __launch_bounds__(NWAVES * 64, 2) mk_fwd(Args args) {
    extern __shared__ __attribute__((aligned(16))) unsigned char lds[];
    Frame F;
    F.lds = (LAS unsigned char*)lds;
    F.wave = __builtin_amdgcn_readfirstlane((int)(threadIdx.x >> 6));
    F.G = gridDim.x; F.c = blockIdx.x; F.ws = args.ws;
    F.ctl = (gu32*)(args.ws + WS_CTL);
    volatile LAS unsigned* MISC = (volatile LAS unsigned*)(F.lds + MISC_OFF);
    for (int u = threadIdx.x; u < (LDS_BYTES - LDSCTL_OFF) / 4; u += NWAVES * 64) ((LAS unsigned*)(F.lds + LDSCTL_OFF))[u] = 0u;
    __syncthreads();
    XcdBarrier bar; bar.bar = (unsigned*)(F.ctl + CW_BAR); bar.x = 0; bar.st = nullptr; bar.wave = F.wave;
    if (MK_N_LAUNCHES == 1) bar = xcd_barrier_post((unsigned*)(F.ctl + CW_BAR), MISC + 8, F.wave);
    const int lo = args.ph_lo, hi = args.ph_hi;
#ifndef ST_MASK
#define ST_MASK 0xff
#endif
#define SM(k) ((ST_MASK >> (k)) & 1)
#ifndef DUP_MASK
#define DUP_MASK 0
#endif
#define DUP(k) ((DUP_MASK >> (k)) & 1)
#ifndef PH_MASK
#define PH_MASK 0x7ff
#endif
#define IN(k) (((PH_MASK >> (k)) & 1) && lo <= (k) && (k) < hi)
#define SEAM(k) do { if (IN(k) && IN((k) + 1)) xcd_barrier(bar); } while (0)

    if (IN(0)) { p0_prologue(F, args); if (DUP(0)) { xcd_barrier(bar); p0_prologue(F, args); } SEAM(0); }
    const unsigned* utab = (const unsigned*)(args.ws + WS_TAB) + (size_t)F.c * NSLOT * ge::GU_DW;
#define UT(slot) (utab + (slot) * ge::GU_DW)
    if (IN(1)) {
        ge::gemm_stream<ge::K_SCALE, 0, true>(F.lds, UT(SL_P1), 9, F.wave);
        ge::gemm_stream<ge::K_SCALE, 0>(F.lds, UT(SL_P1 + 9), 4, F.wave);
        ge::gemm_stream<ge::K_ROT, 0>(F.lds, UT(SL_P1B), 4, F.wave);
        ge::gemm_stream<ge::K_SILU, 0>(F.lds, UT(SL_P1D), 4, F.wave);
        ge::gemm_stream<ge::K_SIG, 0, true>(F.lds, UT(SL_P1E), 8 - GX, F.wave);
        if (DUP(1)) { xcd_barrier(bar); ge::gemm_stream<ge::K_SCALE, 0, true>(F.lds, UT(SL_P1), 9, F.wave); ge::gemm_stream<ge::K_SCALE, 0>(F.lds, UT(SL_P1 + 9), 4, F.wave); ge::gemm_stream<ge::K_ROT, 0>(F.lds, UT(SL_P1B), 4, F.wave); ge::gemm_stream<ge::K_SILU, 0>(F.lds, UT(SL_P1D), 4, F.wave); ge::gemm_stream<ge::K_SIG, 0, true>(F.lds, UT(SL_P1E), 8 - GX, F.wave); }
        SEAM(1); }
    if (IN(2)) { kpt_transpose(F); if (DUP(2)) { xcd_barrier(bar); kpt_transpose(F); } SEAM(2); }
    if (IN(3)) { ge::gemm_stream<ge::K_SCALE, 2>(F.lds, UT(SL_SCAN), 31, F.wave); ge::gemm_stream<ge::K_SIG, 0, true>(F.lds, UT(SL_G2), 2 * GX, F.wave); late_weights_queue(F, args, CW_WORK + 64); p2a_attention(F, CW_WORK); if (DUP(11)) { xcd_barrier(bar); p2a_attention(F, CW_WORK + 128); } if (DUP(12)) { xcd_barrier(bar); late_weights_queue(F, args, CW_WORK + 192); } if (DUP(3)) { xcd_barrier(bar); ge::gemm_stream<ge::K_SCALE, 2>(F.lds, UT(SL_SCAN), 31, F.wave); } SEAM(3); }
    if (IN(4)) { p2b_phase(F, args.in[5]); if (DUP(4)) { xcd_barrier(bar); p2b_phase(F, args.in[5]); } SEAM(4); }
    if (IN(5)) { ge::gemm_stream<ge::K_SCALE, 0>(F.lds, UT(SL_P3), 4, F.wave); ge::gemm_stream<ge::K_FIN, 1>(F.lds, UT(SL_P3B), 8, F.wave); if (DUP(5)) { xcd_barrier(bar); ge::gemm_stream<ge::K_SCALE, 0>(F.lds, UT(SL_P3), 4, F.wave); ge::gemm_stream<ge::K_FIN, 1>(F.lds, UT(SL_P3B), 8, F.wave); } SEAM(5); }
    if (IN(6)) { ge::gemm_stream<ge::K_WO, 0>(F.lds, UT(SL_P4), 4, F.wave); if (DUP(6)) { xcd_barrier(bar); ge::gemm_stream<ge::K_WO, 0>(F.lds, UT(SL_P4), 4, F.wave); } SEAM(6); }
    if (IN(7)) { ln_rows<1>(F, args.out, nullptr, (bf16*)(args.ws + WS_H1B), args.ws + WS_X8, (float*)(args.ws + WS_STAT), args.in[7], args.in[8]); if (DUP(7)) { xcd_barrier(bar); ln_rows<1>(F, args.out, nullptr, (bf16*)(args.ws + WS_H1B), args.ws + WS_X8, (float*)(args.ws + WS_STAT), args.in[7], args.in[8]); } SEAM(7); }
    if (IN(8)) { ge::gemm_stream<ge::K_SWIGLU, 0>(F.lds, UT(SL_P5), 22, F.wave); if (DUP(8)) { xcd_barrier(bar); ge::gemm_stream<ge::K_SWIGLU, 0>(F.lds, UT(SL_P5), 22, F.wave); } ge::gemm_stream<ge::K_PLE, 0, true>(F.lds, UT(SL_P5B), 5, F.wave); SEAM(8); }
    if (IN(9)) { ge::gemm_stream<ge::K_DOWN, 0, false, true>(F.lds, UT(SL_P6), 4, F.wave); if (DUP(9)) { xcd_barrier(bar); ge::gemm_stream<ge::K_DOWN, 0>(F.lds, UT(SL_P6), 4, F.wave); } SEAM(9); }
    if (IN(10)) { ln_rows<0>(F, args.out, args.out, nullptr, nullptr, nullptr, args.in[14], args.in[15]); }
#undef IN
#undef SEAM
}

extern "C" void kernel_launch(void* const* d_in, const int* in_sizes, int n_in, void* d_out, int out_size, void* d_ws, size_t ws_size, hipStream_t stream) {
    static int grid = 0;
    if (grid == 0) {
        if (n_in != 16 || out_size != M * D || ws_size < WS_END) { fprintf(stderr, "kernel_launch: unexpected problem (n_in %d, out %d, ws %zu); nothing launched\n", n_in, out_size, ws_size); grid = -1; return; }
        int dev = 0, cus = 0;
        if (hipGetDevice(&dev) != hipSuccess || hipDeviceGetAttribute(&cus, hipDeviceAttributeMultiprocessorCount, dev) != hipSuccess) { grid = -1; return; }
        if (hipFuncSetAttribute((const void*)mk_fwd, hipFuncAttributeMaxDynamicSharedMemorySize, LDS_BYTES) != hipSuccess) { fprintf(stderr, "kernel_launch: hipFuncSetAttribute failed\n"); grid = -1; return; }
        int per_cu = 0;
        if (hipOccupancyMaxActiveBlocksPerMultiprocessor(&per_cu, (const void*)mk_fwd, NWAVES * 64, LDS_BYTES) != hipSuccess || per_cu < 1) fprintf(stderr, "kernel_launch: occupancy query reports %d\n", per_cu);
        (void)hipGetLastError();
        grid = cus;
        if (grid != 256) { fprintf(stderr, "kernel_launch: built for 256 CUs, device has %d\n", grid); }
    }
    if (grid < 0) return;
    (void)hipMemsetAsync((char*)d_ws + WS_CTL, 0, CTL_ZERO_BYTES, stream);
    Args a{};
    for (int i = 0; i < 16; ++i) a.in[i] = (const float*)d_in[i];
    a.out = (float*)d_out; a.ws = (unsigned char*)d_ws;
    if (MK_N_LAUNCHES == 1) { a.ph_lo = 0; a.ph_hi = N_PHASES; hipLaunchKernelGGL(mk_fwd, dim3(grid), dim3(NWAVES * 64), LDS_BYTES, stream, a); }
    else for (int p = 0; p < N_PHASES; ++p) { a.ph_lo = p; a.ph_hi = p + 1; hipLaunchKernelGGL(mk_fwd, dim3(grid), dim3(NWAVES * 64), LDS_BYTES, stream, a); }
}
```

```cpp
#include <hip/hip_runtime.h>
#include <cstdio>
#include <cstdint>

#ifndef MK_N_LAUNCHES
#define MK_N_LAUNCHES 1
#endif
constexpr int N_PHASES = 11;

#define GAS __attribute__((address_space(1)))
#define LAS __attribute__((address_space(3)))
typedef unsigned short bf16;
typedef short bf16x8 __attribute__((ext_vector_type(8)));
typedef float f32x4 __attribute__((ext_vector_type(4)));
typedef float f32x16 __attribute__((ext_vector_type(16)));
typedef unsigned u32x4 __attribute__((ext_vector_type(4)));
typedef unsigned u32x2 __attribute__((ext_vector_type(2)));
typedef __bf16 bf16x2_t __attribute__((ext_vector_type(2)));
typedef float f32x2_t __attribute__((ext_vector_type(2)));
typedef GAS unsigned gu32;
#define RLX_AGENT __ATOMIC_RELAXED, __HIP_MEMORY_SCOPE_AGENT
#define LDS_WAIT() asm volatile("s_waitcnt lgkmcnt(0)" ::: "memory")
#define VM_WAIT() asm volatile("s_waitcnt vmcnt(0)" ::: "memory")

constexpr int M = 16384, D = 4096, SEQ = 4096, PLE = 256, FF = 11008, NIN = 29696;
constexpr float ALPHA = 1.189207115002721f;
constexpr float QSCALE = 0.12751743082459868f;
constexpr float LN_EPS = 1e-5f, GN_EPS = 1e-6f;
__device__ const float LOG2G[8] = {-4.580368961312e-02f, -2.272007650008e-02f, -1.131531322783e-02f, -5.646563141142e-03f, -2.820519062379e-03f, -1.409570254671e-03f, -7.046129765894e-04f, -3.522634716290e-04f};
__device__ const float INVF[128] = {
1.000000000e+00f, 9.305720329e-01f, 8.659643531e-01f, 8.058421612e-01f, 7.498942614e-01f, 6.978306174e-01f, 6.493816376e-01f, 6.042963862e-01f, 5.623413324e-01f, 5.232990980e-01f, 4.869675338e-01f, 4.531583786e-01f, 4.216965139e-01f, 3.924189806e-01f, 3.651741147e-01f, 3.398208320e-01f, 3.162277639e-01f, 2.942726910e-01f, 2.738419771e-01f, 2.548296750e-01f, 2.371373773e-01f, 2.206734121e-01f, 2.053525001e-01f, 1.910953075e-01f, 1.778279394e-01f, 1.654817164e-01f, 1.539926529e-01f, 1.433012486e-01f, 1.333521307e-01f, 1.240937784e-01f, 1.154782027e-01f, 1.074607819e-01f, 1.000000015e-01f, 9.305720776e-02f, 8.659642935e-02f, 8.058421314e-02f, 7.498941571e-02f, 6.978306174e-02f, 6.493816525e-02f, 6.042964011e-02f, 5.623413250e-02f, 5.232991278e-02f, 4.869675264e-02f, 4.531583562e-02f, 4.216965288e-02f, 3.924189508e-02f, 3.651741147e-02f, 3.398208320e-02f, 3.162277490e-02f, 2.942727134e-02f, 2.738419734e-02f, 2.548296750e-02f, 2.371373773e-02f, 2.206734009e-02f, 2.053525113e-02f, 1.910952851e-02f, 1.778279431e-02f, 1.654816978e-02f, 1.539926510e-02f, 1.433012541e-02f, 1.333521493e-02f, 1.240937784e-02f, 1.154782064e-02f, 1.074607857e-02f, 9.999999776e-03f, 9.305720218e-03f, 8.659643121e-03f, 8.058422245e-03f, 7.498941850e-03f, 6.978305988e-03f, 6.493816152e-03f, 6.042963825e-03f, 5.623413250e-03f, 5.232991185e-03f, 4.869675264e-03f, 4.531583283e-03f, 4.216964822e-03f, 3.924189601e-03f, 3.651741194e-03f, 3.398208413e-03f, 3.162277630e-03f, 2.942727180e-03f, 2.738419687e-03f, 2.548296936e-03f, 2.371373586e-03f, 2.206734149e-03f, 2.053524833e-03f, 1.910952968e-03f, 1.778279431e-03f, 1.654817141e-03f, 1.539926510e-03f, 1.433012541e-03f, 1.333521446e-03f, 1.240937738e-03f, 1.154781901e-03f, 1.074607833e-03f, 1.000000047e-03f, 9.305720450e-04f, 8.659643354e-04f, 8.058421663e-04f, 7.498942432e-04f, 6.978305755e-04f, 6.493816618e-04f, 6.042963942e-04f, 5.623413017e-04f, 5.232990952e-04f, 4.869675322e-04f, 4.531583691e-04f, 4.216965172e-04f, 3.924189659e-04f, 3.651741426e-04f, 3.398208355e-04f, 3.162277571e-04f, 2.942727006e-04f, 2.738419571e-04f, 2.548296761e-04f, 2.371373703e-04f, 2.206734061e-04f, 2.053525095e-04f, 1.910952997e-04f, 1.778279402e-04f, 1.654817170e-04f, 1.539926452e-04f, 1.433012512e-04f, 1.333521504e-04f, 1.240937709e-04f, 1.154782003e-04f, 1.074607862e-04f};

constexpr size_t MiB = 1u << 20;
constexpr size_t WS_CTL = 0, CTL_ZERO_BYTES = 1 * MiB;
constexpr size_t WS_TAB = 1 * MiB;
constexpr size_t WS_WAO = 4 * MiB, WS_WRO = 12 * MiB, WS_WO = 44 * MiB, WS_WGU = 76 * MiB, WS_WD = 248 * MiB, WS_WPG = 334 * MiB, WS_WPU = 366 * MiB;
constexpr size_t WS_PB = 368 * MiB, WS_WIN = 376 * MiB, WS_XB = 608 * MiB;
constexpr size_t WS_QA = 736 * MiB, WS_KA = 832 * MiB, WS_VTG = 928 * MiB, WS_QR = 1024 * MiB, WS_KR = 1088 * MiB, WS_KPT = 1152 * MiB, WS_VTR = 1216 * MiB,
                 WS_GR = 1344 * MiB, WS_GA = 1472 * MiB, WS_GRT = 1600 * MiB;
constexpr size_t WS_ST = 376 * MiB, WS_OG = 632 * MiB, WS_LSE = 728 * MiB;
constexpr size_t WS_OATT = 736 * MiB, WS_RG = 768 * MiB;
constexpr size_t WS_MIX = 896 * MiB, WS_T = 1024 * MiB;
constexpr size_t WS_STAT = 1152 * MiB, WS_H1B = 1408 * MiB;
constexpr size_t WS_HID = 376 * MiB;
constexpr size_t WS_X8 = 1728 * MiB;
constexpr size_t WS_P2B = 896 * MiB;
constexpr size_t WS_WG8 = 1792 * MiB;
constexpr size_t WS_END = 1824 * MiB;
static_assert(WS_OG + 96 * MiB <= WS_LSE && WS_LSE + 2 * MiB <= WS_QA && WS_RG + 128 * MiB <= WS_MIX && WS_T + 128 * MiB <= WS_STAT && WS_H1B + 128 * MiB <= WS_END && WS_HID + 344 * MiB <= WS_OATT && WS_GRT + 128 * MiB <= WS_X8 && WS_X8 + 64 * MiB <= WS_WG8 && WS_WG8 + 32 * MiB <= WS_END, "d_ws map");
constexpr int CW_TMO = 0, CW_WORK = 64;
constexpr int CW_BAR = 4096;

constexpr int RING_BYTES = 131072;
constexpr int LDSCTL_OFF = RING_BYTES, MISC_OFF = LDSCTL_OFF + 320;
constexpr int LDS_BYTES = 147456;
constexpr int NWAVES = 8;

__device__ __forceinline__ unsigned cvtpk(float lo, float hi) { f32x2_t v = {lo, hi}; bf16x2_t b = __builtin_convertvector(v, bf16x2_t); return __builtin_bit_cast(unsigned, b); }
__device__ __forceinline__ unsigned pk_fp8x4(float a, float b, float c, float d) { int w = __builtin_amdgcn_cvt_pk_fp8_f32(a, b, 0, false); w = __builtin_amdgcn_cvt_pk_fp8_f32(c, d, w, true); return (unsigned)w; }
__device__ __forceinline__ float bflo(unsigned w) { return __uint_as_float(w << 16); }
__device__ __forceinline__ float bfhi(unsigned w) { return __uint_as_float(w & 0xffff0000u); }
__device__ __forceinline__ float fexp2(float x) { return __builtin_amdgcn_exp2f(x); }
__device__ __forceinline__ float frcp(float x) { return __builtin_amdgcn_rcpf(x); }
__device__ __forceinline__ float sigmoidf_(float x) { return frcp(1.0f + fexp2(-1.4426950408889634f * x)); }
__device__ __forceinline__ float siluf_(float x) { return x * sigmoidf_(x); }
__device__ __forceinline__ void sincos_pos(float a, float& s, float& c) {
    const float k = rintf(a * 0.15915494309189535f);
    float r = fmaf(-k, 6.28125f, a);
    r = fmaf(-k, 1.935307179586232e-3f, r);
    const float rv = r * 0.15915494309189535f;
    s = __builtin_amdgcn_sinf(rv); c = __builtin_amdgcn_cosf(rv);
}
__device__ __forceinline__ int lane_now() { int l; asm volatile("v_mbcnt_lo_u32_b32 %0, -1, 0\n\tv_mbcnt_hi_u32_b32 %0, -1, %0" : "=v"(l)); return l; }
__device__ __forceinline__ float wave_sum(float v) {
#pragma unroll
    for (int o = 1; o < 64; o <<= 1) v += __shfl_xor(v, o);
    return v;
}

#define XB_TMO      128
#define XB_XCNT(j)  (256  + 64 * (j))
#define XB_XSUB(j)  (1280 + 64 * (j))
#define XB_XGEN(j)  (2304 + 64 * (j))
#define XB_TOP      3328
#define XB_TOPGEN   3392
#define XCD_BAR_WORDS 3456
#define XB_SPIN_CAP (1u << 18)
__device__ __forceinline__ unsigned xb_ld(unsigned* p)              { return __hip_atomic_load(p, __ATOMIC_RELAXED, __HIP_MEMORY_SCOPE_AGENT); }
__device__ __forceinline__ unsigned xb_add(unsigned* p, unsigned v) { return __hip_atomic_fetch_add(p, v, __ATOMIC_RELAXED, __HIP_MEMORY_SCOPE_AGENT); }
__device__ __forceinline__ unsigned xb_xcc_id() { return (unsigned)__builtin_amdgcn_s_getreg((3 << 11) | 20) & 0xFu; }
#define XB_SPIN(cond, bar) do { unsigned _sp = 0; while (cond) { __builtin_amdgcn_s_sleep(1); \
    if ((++_sp & 255u) == 0u) { if (xb_ld(&(bar)[XB_TMO])) break; if (_sp > XB_SPIN_CAP) { atomicAdd(&(bar)[XB_TMO], 1u); break; } } } } while (0)
struct XcdBarrier { unsigned* bar; unsigned x; volatile LAS unsigned* st; int wave; };
__device__ __forceinline__ XcdBarrier xcd_barrier_post(unsigned* bar, volatile LAS unsigned* st, int wave) {
    XcdBarrier b; b.bar = bar; b.x = xb_xcc_id(); b.st = st; b.wave = wave;
    if (wave == 0 && lane_now() == 0) (void)xb_add(&bar[XB_XCNT(b.x)], 1u);
    return b;
}
__device__ __forceinline__ void xcd_barrier_complete(unsigned* bar, unsigned x, unsigned& nloc, unsigned& nx) {
    const unsigned G = gridDim.x * gridDim.y * gridDim.z;
    unsigned sum, cnt, mine, sp = 0u;
    for (;;) {
        sum = 0u; cnt = 0u; mine = 0u;
#pragma unroll
        for (unsigned j = 0; j < 16; ++j) { const unsigned c = xb_ld(&bar[XB_XCNT(j)]); sum += c; cnt += (c > 0u) ? 1u : 0u; mine = (j == x) ? c : mine; }
        if (sum == G) break;
        __builtin_amdgcn_s_sleep(1);
        if ((++sp & 255u) == 0u) { if (xb_ld(&bar[XB_TMO])) break; if (sp > XB_SPIN_CAP) { atomicAdd(&bar[XB_TMO], 1u); break; } }
    }
    nloc = mine > 0u ? mine : 1u; nx = cnt > 0u ? cnt : 1u;
}
__device__ __forceinline__ void xcd_barrier(const XcdBarrier& b) {
    asm volatile("s_waitcnt vmcnt(0)" ::: "memory");
    __syncthreads();
    if (b.wave == 0 && lane_now() == 0) {
        unsigned* bar = b.bar;
        __builtin_amdgcn_s_waitcnt(0);
        unsigned nloc = b.st[0], nx = b.st[1];
        if (nloc == 0u) { xcd_barrier_complete(bar, b.x, nloc, nx); b.st[0] = nloc; b.st[1] = nx; }
        const unsigned old = xb_add(&bar[XB_XSUB(b.x)], 1u);
        const unsigned gen = old / nloc;
        if (old + 1u == (gen + 1u) * nloc) {
            __builtin_amdgcn_fence(__ATOMIC_RELEASE, "agent");
            asm volatile("s_waitcnt vmcnt(0)" ::: "memory");
            const unsigned og = xb_add(&bar[XB_TOP], 1u);
            const unsigned tg = og / nx;
            if (og + 1u == (tg + 1u) * nx) xb_add(&bar[XB_TOPGEN], 1u);
            else XB_SPIN(xb_ld(&bar[XB_TOPGEN]) == tg, bar);
            __builtin_amdgcn_fence(__ATOMIC_ACQUIRE, "agent");
            xb_add(&bar[XB_XGEN(b.x)], 1u);
            asm volatile("s_waitcnt vmcnt(0)" ::: "memory");
        } else {
            XB_SPIN(xb_ld(&bar[XB_XGEN(b.x)]) == gen, bar);
            __builtin_amdgcn_fence(__ATOMIC_ACQUIRE, "agent");
            asm volatile("s_waitcnt vmcnt(0)" ::: "memory");
        }
    }
    __syncthreads();
}

namespace ge {
constexpr int BM = 256, BK = 64, HALF = 128, HTB = HALF * BK * 2, STAGE_BYTES = 8 * HTB;
__host__ __device__ __forceinline__ int lds_byte(int r, int c) { const int st = (r >> 4) * 2 + (c >> 5), rr = r & 15, cc = c & 31, ob = rr * 64 + cc * 2; return st * 1024 + (ob ^ (((ob >> 9) & 1) << 5)); }
__host__ __device__ __forceinline__ void stage_rc(int b, int& R, int& C) { const int st = b / 1024, sb = b % 1024, swz = sb ^ (((sb >> 9) & 1) << 5); R = (st >> 1) * 16 + swz / 64; C = (st & 1) * 32 + (swz % 64) / 2; }
__host__ __device__ __forceinline__ int perm32(int rho) { const int n = rho >> 4, i = rho & 15; return 8 * (i >> 2) + 4 * n + (i & 3); }

enum Kind { K_SCALE = 0, K_ROT = 1, K_ROTT = 2, K_SILU = 3, K_SIG = 4, K_MID = 5, K_FIN = 6, K_WO = 7, K_SWIGLU = 8, K_PLE = 9, K_DOWN = 10 };
struct GU {
    const char* A; const char* B;
    char* out;
    const char* x0; const char* x1;
    unsigned sA, sB;
    int nt;
    unsigned ldo, ldx;
    int i0, i1;
    int pad[3];
};
static_assert(sizeof(GU) == 80, "unit table entry");
constexpr int GU_DW = 20;
__device__ __forceinline__ void tile_of(int local, int nM, int nN, int& pm, int& pn) {
    const int nwg = nM * nN; int wgid = local;
    { const int q = nwg / 8, r = nwg % 8, xcd = wgid % 8, off = wgid / 8; wgid = (xcd < r ? xcd * (q + 1) : r * (q + 1) + (xcd - r) * q) + off; }
    const int nig = 8 * nN, gid = wgid / nig, fm = gid * 8, gsz = (nM - fm) < 8 ? (nM - fm) : 8;
    pm = fm + ((wgid % nig) % gsz); pn = (wgid % nig) / gsz;
}

typedef f32x4 Acc[2][2][4][2];
#define EPI_FENCE() do { asm volatile("" ::: "memory"); __builtin_amdgcn_sched_barrier(0); } while (0)
__device__ __forceinline__ u32x4 pack8(const f32x4 a, const f32x4 b) { u32x4 w; w.x = cvtpk(a[0], a[1]); w.y = cvtpk(a[2], a[3]); w.z = cvtpk(b[0], b[1]); w.w = cvtpk(b[2], b[3]); return w; }
__device__ __forceinline__ void unpack8(const u32x4 w, f32x4& a, f32x4& b) { a = (f32x4){bflo(w.x), bfhi(w.x), bflo(w.y), bfhi(w.y)}; b = (f32x4){bflo(w.z), bfhi(w.z), bflo(w.w), bfhi(w.w)}; }

template <int MODE>
__device__ __forceinline__ void epi_bf16(Acc& acc, const GU& u, int r0, int c0) {
    const float f = __int_as_float(u.i0);
#pragma unroll
    for (int ai = 0; ai < 2; ++ai)
#pragma unroll
        for (int m = 0; m < 4; ++m) { EPI_FENCE(); char* rowp = u.out + (size_t)(r0 + ai * 128 + m * 16) * u.ldo + (size_t)c0 * 2;
#pragma unroll
            for (int bj = 0; bj < 2; ++bj) { const f32x4 a0 = acc[ai][bj][m][0], a1 = acc[ai][bj][m][1]; f32x4 v0, v1;
                if (MODE == 0) { v0 = a0 * f; v1 = a1 * f; }
                else if (MODE == 1) { v0 = (f32x4){siluf_(a0[0] * f), siluf_(a0[1] * f), siluf_(a0[2] * f), siluf_(a0[3] * f)}; v1 = (f32x4){siluf_(a1[0] * f), siluf_(a1[1] * f), siluf_(a1[2] * f), siluf_(a1[3] * f)}; }
                else { v0 = (f32x4){sigmoidf_(a0[0] * f), sigmoidf_(a0[1] * f), sigmoidf_(a0[2] * f), sigmoidf_(a0[3] * f)}; v1 = (f32x4){sigmoidf_(a1[0] * f), sigmoidf_(a1[1] * f), sigmoidf_(a1[2] * f), sigmoidf_(a1[3] * f)}; }
                *(GAS u32x4*)(rowp + bj * 256) = pack8(v0, v1); } }
}
__device__ __forceinline__ void mid_scale(Acc& acc, const GU& u, int wr, int wc) {
    const int ln = lane_now(), r0 = wr * 64 + (ln & 15), c0 = wc * 32 + 8 * (ln >> 4);
#pragma unroll
    for (int ai = 0; ai < 2; ++ai)
#pragma unroll
        for (int mp = 0; mp < 2; ++mp) { EPI_FENCE(); u32x4 wa[2][2], wg[2][2];
#pragma unroll
            for (int mm = 0; mm < 2; ++mm) { const size_t ro = (size_t)(r0 + ai * 128 + (2 * mp + mm) * 16) * u.ldx + (size_t)c0 * 2;
#pragma unroll
                for (int bj = 0; bj < 2; ++bj) { wa[mm][bj] = *(const GAS u32x4*)(u.x0 + ro + bj * 256); wg[mm][bj] = *(const GAS u32x4*)(u.x1 + ro + bj * 256); } }
#pragma unroll
            for (int mm = 0; mm < 2; ++mm)
#pragma unroll
                for (int bj = 0; bj < 2; ++bj) { const int m = 2 * mp + mm; f32x4 a0, a1, g0, g1; unpack8(wa[mm][bj], a0, a1); unpack8(wg[mm][bj], g0, g1);
#pragma unroll
                    for (int t = 0; t < 4; ++t) { acc[ai][bj][m][0][t] *= a0[t] * frcp(g0[t]); acc[ai][bj][m][1][t] *= a1[t] * frcp(g1[t]); } } }
}
#define KM(k) (KIND == (k))
template <int KIND>
__device__ __forceinline__ void epilogue(Acc& acc, const GU& u, int wr, int wc) {
    const int ln = lane_now(), r0 = wr * 64 + (ln & 15), c0 = wc * 32 + 8 * (ln >> 4);
    switch (KIND) {
    case K_SCALE: if constexpr (KM(K_SCALE)) { epi_bf16<0>(acc, u, r0, c0); } break;
    case K_SILU: if constexpr (KM(K_SILU)) { epi_bf16<1>(acc, u, r0, c0); } break;
    case K_SIG: if constexpr (KM(K_SIG)) { epi_bf16<2>(acc, u, r0, c0); } break;
    case K_ROT: if constexpr (KM(K_ROT)) {
        const float f = __int_as_float(u.i1);
        float invf[8];
#pragma unroll
        for (int j = 0; j < 8; ++j) invf[j] = INVF[c0 + j];
#pragma unroll
        for (int ai = 0; ai < 2; ++ai)
#pragma unroll
            for (int m = 0; m < 4; ++m) { EPI_FENCE(); const int row = r0 + ai * 128 + m * 16; const float pos = (float)((u.i0 + row) & (SEQ - 1));
                char* rowp = u.out + (size_t)row * u.ldo + (size_t)c0 * 2; f32x4 o1[2], o2[2];
#pragma unroll
                for (int n = 0; n < 2; ++n)
#pragma unroll
                    for (int t = 0; t < 4; ++t) { float s, c; sincos_pos(pos * invf[4 * n + t], s, c); const float t1 = acc[ai][0][m][n][t], t2 = acc[ai][1][m][n][t];
                        o1[n][t] = (t1 * c - t2 * s) * f; o2[n][t] = (t1 * s + t2 * c) * f; }
                *(GAS u32x4*)(rowp) = pack8(o1[0], o1[1]); *(GAS u32x4*)(rowp + 256) = pack8(o2[0], o2[1]); }
    } break;
    case K_ROTT: if constexpr (KM(K_ROTT)) {
        const float lg = LOG2G[u.i1]; float dec[8];
#pragma unroll
        for (int j = 0; j < 8; ++j) dec[j] = 0.0625f * fexp2((float)(127 - (c0 + j)) * lg);
#pragma unroll
        for (int m = 0; m < 4; ++m) { const int row = r0 + m * 16; const float iv = INVF[row];
#pragma unroll
            for (int bj = 0; bj < 2; ++bj) { EPI_FENCE(); f32x4 o1[2], o2[2];
#pragma unroll
                for (int n = 0; n < 2; ++n)
#pragma unroll
                    for (int t = 0; t < 4; ++t) { const float pos = (float)((u.i0 + bj * 128 + c0 + 4 * n + t) & (SEQ - 1)); float s, c; sincos_pos(pos * iv, s, c);
                        const float t1 = acc[0][bj][m][n][t], t2 = acc[1][bj][m][n][t], d = dec[4 * n + t];
                        o1[n][t] = (t1 * c - t2 * s) * d; o2[n][t] = (t1 * s + t2 * c) * d; }
                char* p1 = u.out + (size_t)row * u.ldo + (size_t)(bj * 128 + c0) * 2;
                *(GAS u32x4*)(p1) = pack8(o1[0], o1[1]); *(GAS u32x4*)(p1 + (size_t)128 * u.ldo) = pack8(o2[0], o2[1]); } }
    } break;
    case K_FIN: if constexpr (KM(K_FIN)) {
#pragma unroll
        for (int ai = 0; ai < 2; ++ai) { EPI_FENCE(); u32x4 wg[4][2];
#pragma unroll
            for (int m = 0; m < 4; ++m) { const size_t ro = (size_t)(r0 + ai * 128 + m * 16) * u.ldx + (size_t)c0 * 2;
#pragma unroll
                for (int bj = 0; bj < 2; ++bj) wg[m][bj] = *(const GAS u32x4*)(u.x1 + ro + bj * 256); }
#pragma unroll
            for (int m = 0; m < 4; ++m) { char* rowp = u.out + (size_t)(r0 + ai * 128 + m * 16) * u.ldo + (size_t)c0 * 2;
#pragma unroll
                for (int bj = 0; bj < 2; ++bj) { f32x4 g0, g1; unpack8(wg[m][bj], g0, g1);
                    *(GAS u32x4*)(rowp + bj * 256) = pack8(acc[ai][bj][m][0] * g0, acc[ai][bj][m][1] * g1); } } }
    } break;
    case K_WO: if constexpr (KM(K_WO)) {
        const float f = __int_as_float(u.i0);
#pragma unroll
        for (int ai = 0; ai < 2; ++ai)
#pragma unroll
            for (int mp = 0; mp < 2; ++mp) { EPI_FENCE(); f32x4 xv[2][2][2];
#pragma unroll
                for (int mm = 0; mm < 2; ++mm) { const size_t xo = (size_t)(r0 + ai * 128 + (2 * mp + mm) * 16) * u.ldx + (size_t)c0 * 4;
#pragma unroll
                    for (int bj = 0; bj < 2; ++bj) { xv[mm][bj][0] = *(const GAS f32x4*)(u.x0 + xo + bj * 512); xv[mm][bj][1] = *(const GAS f32x4*)(u.x0 + xo + bj * 512 + 16); } }
#pragma unroll
                for (int mm = 0; mm < 2; ++mm) { const int m = 2 * mp + mm; char* rowp = u.out + (size_t)(r0 + ai * 128 + m * 16) * u.ldo + (size_t)c0 * 4;
#pragma unroll
                    for (int bj = 0; bj < 2; ++bj) { *(GAS f32x4*)(rowp + bj * 512) = xv[mm][bj][0] * f + acc[ai][bj][m][0]; *(GAS f32x4*)(rowp + bj * 512 + 16) = xv[mm][bj][1] * f + acc[ai][bj][m][1]; } } }
    } break;
    case K_SWIGLU: if constexpr (KM(K_SWIGLU)) {
#pragma unroll
        for (int ai = 0; ai < 2; ++ai)
#pragma unroll
            for (int m = 0; m < 4; ++m) { EPI_FENCE(); char* rowp = u.out + (size_t)(r0 + ai * 128 + m * 16) * u.ldo + (size_t)c0 * 2; f32x4 h0, h1;
#pragma unroll
                for (int t = 0; t < 4; ++t) { h0[t] = siluf_(acc[ai][0][m][0][t]) * acc[ai][1][m][0][t]; h1[t] = siluf_(acc[ai][0][m][1][t]) * acc[ai][1][m][1][t]; }
                *(GAS u32x4*)(rowp) = pack8(h0, h1); }
    } break;
    case K_PLE: if constexpr (KM(K_PLE)) {
#pragma unroll
        for (int ai = 0; ai < 2; ++ai) { EPI_FENCE(); u32x4 wt[4][2];
#pragma unroll
            for (int m = 0; m < 4; ++m) { const size_t to = (size_t)(r0 + ai * 128 + m * 16) * u.ldx + (size_t)c0 * 2;
#pragma unroll
                for (int bj = 0; bj < 2; ++bj) wt[m][bj] = *(const GAS u32x4*)(u.x0 + to + bj * 256); }
#pragma unroll
            for (int m = 0; m < 4; ++m) { char* rowp = u.out + (size_t)(r0 + ai * 128 + m * 16) * u.ldo + (size_t)c0 * 2;
#pragma unroll
                for (int bj = 0; bj < 2; ++bj) { f32x4 t0, t1; unpack8(wt[m][bj], t0, t1); const f32x4 a0 = acc[ai][bj][m][0], a1 = acc[ai][bj][m][1];
                    const f32x4 o0 = {sigmoidf_(a0[0]) * t0[0], sigmoidf_(a0[1]) * t0[1], sigmoidf_(a0[2]) * t0[2], sigmoidf_(a0[3]) * t0[3]};
                    const f32x4 o1 = {sigmoidf_(a1[0]) * t1[0], sigmoidf_(a1[1]) * t1[1], sigmoidf_(a1[2]) * t1[2], sigmoidf_(a1[3]) * t1[3]};
                    *(GAS u32x4*)(rowp + bj * 256) = pack8(o0, o1); } } }
    } break;
    case K_DOWN: if constexpr (KM(K_DOWN)) {
        const GAS f32x2_t* stat = (const GAS f32x2_t*)u.x0 + u.i0; const GAS f32x4* gb = (const GAS f32x4*)((const GAS f32x2_t*)u.x0 + M + u.i1 + c0);
        f32x4 gbv[2][4];
#pragma unroll
        for (int bj = 0; bj < 2; ++bj)
#pragma unroll
            for (int j = 0; j < 4; ++j) gbv[bj][j] = gb[bj * 64 + j];
#pragma unroll
        for (int ai = 0; ai < 2; ++ai)
#pragma unroll
            for (int mp = 0; mp < 2; ++mp) { EPI_FENCE(); f32x4 xv[2][2][2]; u32x4 pl[2][2]; f32x2_t st[2];
#pragma unroll
                for (int mm = 0; mm < 2; ++mm) { const int row = r0 + ai * 128 + (2 * mp + mm) * 16; const char* xp = u.out + (size_t)row * u.ldo + (size_t)c0 * 4; const size_t po = (size_t)row * u.ldx + (size_t)c0 * 2; st[mm] = stat[row];
#pragma unroll
                    for (int bj = 0; bj < 2; ++bj) { xv[mm][bj][0] = *(const GAS f32x4*)(xp + bj * 512); xv[mm][bj][1] = *(const GAS f32x4*)(xp + bj * 512 + 16); pl[mm][bj] = *(const GAS u32x4*)(u.x1 + po + bj * 256); } }
#pragma unroll
                for (int mm = 0; mm < 2; ++mm) { const int m = 2 * mp + mm; char* rowp = (char*)u.x1 + ((ptrdiff_t)WS_P2B - (ptrdiff_t)WS_T) + (size_t)(r0 + ai * 128 + m * 16) * u.ldx + (size_t)c0 * 2; const float mu = st[mm][0], rs = st[mm][1];
#pragma unroll
                    for (int bj = 0; bj < 2; ++bj) { f32x4 p0, p1; unpack8(pl[mm][bj], p0, p1); const f32x4 x0 = xv[mm][bj][0], x1 = xv[mm][bj][1], a0 = acc[ai][bj][m][0], a1 = acc[ai][bj][m][1];
                        const f32x4 g01 = gbv[bj][0], g23 = gbv[bj][1], g45 = gbv[bj][2], g67 = gbv[bj][3];
                        const f32x4 o0 = {(x0[0] - mu) * rs * g01[0] + g01[1] + p0[0] + a0[0], (x0[1] - mu) * rs * g01[2] + g01[3] + p0[1] + a0[1], (x0[2] - mu) * rs * g23[0] + g23[1] + p0[2] + a0[2], (x0[3] - mu) * rs * g23[2] + g23[3] + p0[3] + a0[3]};
                        const f32x4 o1 = {(x1[0] - mu) * rs * g45[0] + g45[1] + p1[0] + a1[0], (x1[1] - mu) * rs * g45[2] + g45[3] + p1[1] + a1[1], (x1[2] - mu) * rs * g67[0] + g67[1] + p1[2] + a1[2], (x1[3] - mu) * rs * g67[2] + g67[3] + p1[3] + a1[3]};
                        *(GAS u32x4*)(rowp + bj * 256) = pack8(o0, o1); } } }
    } break;
    default: break;
    }
}

#define CAS __attribute__((address_space(4)))
__device__ __forceinline__ bool fetch_unit(const unsigned* tab, int i, int count, GU& u) {
    if (i >= count) return false;
    const CAS unsigned long long* e8 = (const CAS unsigned long long*)(const CAS void*)(tab + (size_t)i * GU_DW);
    const CAS unsigned* e4 = (const CAS unsigned*)e8;
    u.A = (const char*)e8[0]; u.B = (const char*)e8[1]; u.out = (char*)e8[2]; u.x0 = (const char*)e8[3]; u.x1 = (const char*)e8[4];
    u.sA = e4[10]; u.sB = e4[11]; u.nt = (int)e4[12]; u.ldo = e4[13]; u.ldx = e4[14]; u.i0 = (int)e4[15]; u.i1 = (int)e4[16];
    return u.nt != 0;
}
template <int KIND, int CHAIN, bool FP8 = false, bool ALT = false>
__device__ __forceinline__ void gemm_stream(LAS unsigned char* lds, const unsigned* tab, int count, int wid) {
    const int wr = wid >> 2, wc = wid & 3;
    int aoff, boff; { const int lane = lane_now(), fr = lane & 15, fq = lane >> 4; aoff = lds_byte(wr * 64 + fr, fq * 8); boff = lds_byte(wc * 32 + fr, fq * 8); }
#define GE_LANE_RC(rA0, rB0, cc0) unsigned rA0, rB0, cc0; { const int _t = wid * 64 + lane_now(); int R, C; stage_rc(_t * 16, R, C); rA0 = (unsigned)R; rB0 = (unsigned)((R & ~31) + perm32(R & 31)); cc0 = (unsigned)C * 2u; }
    const unsigned ldsw = (unsigned)wid * 1024u;
    const unsigned ldsbase = (unsigned)__builtin_amdgcn_readfirstlane((int)((unsigned)(size_t)lds + ldsw));
#define GE_SA(b, h) (((b) * 2 + (h)) * HTB)
#define GE_SB(b, h) ((4 + (b) * 2 + (h)) * HTB)
#define GE_DMA(sbase, voff, ldsaddr) do { unsigned _keep; asm volatile("s_mov_b32 %0, m0\n\ts_mov_b32 m0, %3\n\ts_nop 0\n\tglobal_load_lds_dwordx4 %1, %2\n\ts_mov_b32 m0, %0" \
        : "=&s"(_keep) : "v"(voff), "s"(sbase), "s"(ldsaddr) : "memory"); } while (0)
#define GE_STAGE(bufoff, gbase, voff, s64) do { const char* _b0 = (const char*)(gbase); const char* _b1 = _b0 + (s64); \
        GE_DMA(_b0, (voff), ldsbase + (unsigned)(bufoff)); GE_DMA(_b1, (voff), ldsbase + (unsigned)(bufoff) + 8192u); } while (0)
#define GE_LDA(dst, b, h) do { _Pragma("unroll") for (int m = 0; m < 4; ++m) _Pragma("unroll") for (int k = 0; k < 2; ++k) dst[m][k] = *(const LAS bf16x8*)(lds + GE_SA(b, h) + aoff + m * 2048 + k * 1024); } while (0)
#define GE_LDB(dst, b, h) do { _Pragma("unroll") for (int n = 0; n < 2; ++n) _Pragma("unroll") for (int k = 0; k < 2; ++k) dst[n][k] = *(const LAS bf16x8*)(lds + GE_SB(b, h) + boff + n * 2048 + k * 1024); } while (0)
#define GE_MMA(ai, bj, At, Bt) do { __builtin_amdgcn_s_setprio(1); \
        if (FP8) { typedef int i4_t __attribute__((ext_vector_type(4))); typedef int i8_t __attribute__((ext_vector_type(8))); \
            _Pragma("unroll") for (int m = 0; m < 4; ++m) _Pragma("unroll") for (int n = 0; n < 2; ++n) { \
                const i8_t a8 = __builtin_shufflevector(__builtin_bit_cast(i4_t, At[m][0]), __builtin_bit_cast(i4_t, At[m][1]), 0, 1, 2, 3, 4, 5, 6, 7); \
                const i8_t b8 = __builtin_shufflevector(__builtin_bit_cast(i4_t, Bt[n][0]), __builtin_bit_cast(i4_t, Bt[n][1]), 0, 1, 2, 3, 4, 5, 6, 7); \
                acc[ai][bj][m][n] = __builtin_amdgcn_mfma_scale_f32_16x16x128_f8f6f4(b8, a8, acc[ai][bj][m][n], 0, 0, 0, 0x7F7F7F7F, 0, 0x79797979); \
                asm volatile("" : "+v"(acc[ai][bj][m][n])); } } \
        else { _Pragma("unroll") for (int m = 0; m < 4; ++m) _Pragma("unroll") for (int n = 0; n < 2; ++n) _Pragma("unroll") for (int k = 0; k < 2; ++k) \
            acc[ai][bj][m][n] = __builtin_amdgcn_mfma_f32_16x16x32_bf16(Bt[n][k], At[m][k], acc[ai][bj][m][n], 0, 0, 0); } \
        __builtin_amdgcn_s_setprio(0); } while (0)
#define GE_WAIT_V(n) asm volatile("s_waitcnt vmcnt(" #n ")" ::: "memory")
#define GE_WAIT_L(n) asm volatile("s_waitcnt lgkmcnt(" #n ")" ::: "memory")
#define GE_BAR __builtin_amdgcn_s_barrier()
#define GE_SCHED __builtin_amdgcn_sched_barrier(0)
#define GE_ZERO() do { _Pragma("unroll") for (int a = 0; a < 2; ++a) _Pragma("unroll") for (int b = 0; b < 2; ++b) _Pragma("unroll") for (int m = 0; m < 4; ++m) _Pragma("unroll") for (int n = 0; n < 2; ++n) acc[a][b][m][n] = (f32x4){0.f, 0.f, 0.f, 0.f}; } while (0)
#define GE_BODY(a1, a2, b2, a3, b3, v2A, v2B, h2A, h2B, q2A, q2B) do { \
            GE_LDB(B0, 0, 0); GE_LDB(B1, 0, 1); GE_SCHED; GE_LDA(At, 0, 0); GE_STAGE(GE_SA(1, 1), (a1) + chA, cvA, cqA); \
            GE_WAIT_V(8); GE_WAIT_L(0); GE_BAR; GE_MMA(0, 0, At, B0); GE_MMA(0, 1, At, B1); GE_BAR; GE_SCHED; \
            GE_LDA(At, 0, 1); GE_STAGE(GE_SB(0, 0), (b2), v2B, q2B); GE_STAGE(GE_SB(0, 1), (b2) + (h2B), v2B, q2B); GE_STAGE(GE_SA(0, 0), (a2), v2A, q2A); \
            GE_WAIT_V(8); GE_WAIT_L(0); GE_BAR; GE_MMA(1, 0, At, B0); GE_MMA(1, 1, At, B1); GE_BAR; GE_SCHED; \
            GE_LDB(B0, 1, 0); GE_LDB(B1, 1, 1); GE_SCHED; GE_LDA(At, 1, 0); GE_STAGE(GE_SA(0, 1), (a2) + (h2A), v2A, q2A); \
            GE_WAIT_V(8); GE_WAIT_L(0); GE_BAR; GE_MMA(0, 0, At, B0); GE_MMA(0, 1, At, B1); GE_BAR; GE_SCHED; \
            GE_LDA(At, 1, 1); GE_STAGE(GE_SB(1, 0), (b3), v2B, q2B); GE_STAGE(GE_SB(1, 1), (b3) + (h2B), v2B, q2B); GE_STAGE(GE_SA(1, 0), (a3), v2A, q2A); \
            GE_WAIT_V(8); GE_WAIT_L(0); GE_BAR; GE_MMA(1, 0, At, B0); GE_MMA(1, 1, At, B1); GE_BAR; GE_SCHED; } while (0)
    GU cur, nxt; int ui = 0;
    if (!fetch_unit(tab, 0, count, cur)) return;
    Acc acc; GE_ZERO();
    bf16x8 At[4][2], B0[2][2], B1[2][2];
    unsigned cvA, cvB; { GE_LANE_RC(rA0, rB0, cc0); cvA = rA0 * cur.sA + cc0; cvB = rB0 * cur.sB + cc0; }
    const char* cA = cur.A; const char* cB = cur.B; size_t chA = (size_t)128 * cur.sA, chB = (size_t)128 * cur.sB, cqA = (size_t)64 * cur.sA, cqB = (size_t)64 * cur.sB;
    ptrdiff_t kstep = ALT ? -128 : 128;
    GE_STAGE(GE_SB(0, 0), cB, cvB, cqB); GE_STAGE(GE_SB(0, 1), cB + chB, cvB, cqB); GE_STAGE(GE_SA(0, 0), cA, cvA, cqA); GE_STAGE(GE_SA(0, 1), cA + chA, cvA, cqA);
    if (wr == 1) GE_BAR;
    GE_WAIT_V(2); GE_BAR;
    GE_STAGE(GE_SB(1, 0), cB + kstep, cvB, cqB); GE_STAGE(GE_SA(1, 0), cA + kstep, cvA, cqA); GE_STAGE(GE_SB(1, 1), cB + chB + kstep, cvB, cqB);
    GE_WAIT_V(6); GE_BAR;
    for (;;) {
        const bool has_next = fetch_unit(tab, ui + 1, count, nxt);
        const int nt = cur.nt;
        for (int t = 0; t < nt - 2; t += 2) {
            const char* a1 = cA + (ptrdiff_t)(t + 1) * kstep; const char* a2 = cA + (ptrdiff_t)(t + 2) * kstep; const char* b2 = cB + (ptrdiff_t)(t + 2) * kstep;
            GE_BODY(a1, a2, b2, a2 + kstep, b2 + kstep, cvA, cvB, chA, chB, cqA, cqB);
        }
        {
            const char* nA = cA; const char* nB = cB; size_t nhA = chA, nhB = chB, nqA = cqA, nqB = cqB; unsigned nvA = cvA, nvB = cvB;
            if (has_next) { nA = nxt.A; nB = nxt.B; nhA = (size_t)128 * nxt.sA; nhB = (size_t)128 * nxt.sB; nqA = (size_t)64 * nxt.sA; nqB = (size_t)64 * nxt.sB; GE_LANE_RC(rA0, rB0, cc0); nvA = rA0 * nxt.sA + cc0; nvB = rB0 * nxt.sB + cc0; }
            const char* a1 = cA + (ptrdiff_t)(nt - 1) * kstep; const ptrdiff_t nks = ALT ? (has_next ? -kstep : kstep) : 128;
            GE_BODY(a1, nA, nB, nA + nks, nB + nks, nvA, nvB, nhA, nhB, nqA, nqB);
            if (wr == 0) GE_BAR;
            if (CHAIN == 1 && !(ui & 1)) { mid_scale(acc, cur, wr, wc); }
            else if (CHAIN == 2) { epilogue<KIND>(acc, cur, wr, wc); const float f = __int_as_float(cur.i1);
                _Pragma("unroll") for (int a = 0; a < 2; ++a) _Pragma("unroll") for (int b = 0; b < 2; ++b) _Pragma("unroll") for (int m = 0; m < 4; ++m) _Pragma("unroll") for (int n = 0; n < 2; ++n) { acc[a][b][m][n] = acc[a][b][m][n] * f; asm volatile("" : "+v"(acc[a][b][m][n])); } }
            else { epilogue<KIND>(acc, cur, wr, wc); if (has_next) GE_ZERO(); }
            if (!has_next) break;
            cur = nxt; cA = nA; cB = nB; chA = nhA; chB = nhB; cqA = nqA; cqB = nqB; cvA = nvA; cvB = nvB; if (ALT) kstep = -kstep;
            ++ui;
            if (wr == 1) GE_BAR;
        }
    }
    GE_WAIT_V(0);
    GE_BAR;
#undef GE_BODY
#undef GE_LANE_RC
#undef GE_SA
#undef GE_SB
#undef GE_STAGE
#undef GE_LDA
#undef GE_LDB
#undef GE_MMA
#undef GE_WAIT_V
#undef GE_WAIT_L
#undef GE_BAR
#undef GE_SCHED
#undef GE_ZERO
}
}

struct Args { const float* in[16]; float* out; unsigned char* ws; int ph_lo, ph_hi; };
struct Frame {
    LAS unsigned char* lds;
    gu32* ctl;
    int wave, G, c;
    unsigned char* ws;
};

__device__ __forceinline__ int perm_tile_token0(int g, int tile) {
    const int sh = 2 * g, L = SEQ >> sh, m0 = tile * 256, b = m0 >> 12, rem = m0 & (SEQ - 1), r = rem / L, j0 = rem % L;
    return (b << 12) + (j0 << sh) + r;
}

constexpr int SL_P1 = 0, SL_P1B = 13, SL_P1C = 17, SL_P1D = 19, SL_P1E = 23, SL_P3 = 31, SL_P3B = 35, SL_P4 = 43, SL_P5 = 47, SL_P5B = 69, SL_P6 = 74, SL_SCAN = 78, SL_G2 = 109, GX = 3, NSLOT = 109 + 2 * GX;
__device__ __forceinline__ void make_unit(int slot, int c, unsigned char* ws, const float* x, float* outp, ge::GU& u) {
    const char* xb = (const char*)(ws + WS_XB); const char* win = (const char*)(ws + WS_WIN);
    const unsigned rowK = D * 2;
    u.A = nullptr; u.B = nullptr; u.out = nullptr; u.x0 = nullptr; u.x1 = nullptr; u.sA = rowK; u.sB = rowK; u.nt = D / 64; u.ldo = 0; u.ldx = 0; u.i0 = __float_as_int(1.0f); u.i1 = 0; u.pad[0] = u.pad[1] = u.pad[2] = 0;
    if (slot >= SL_G2) {
        const int idx = c >> 3;
        if (c < 64 || (idx % 3) == 2) { u.nt = 0; return; }
        const int k = (idx - 8) - ((idx - 8) / 3 + 1), j = slot - SL_G2;
        c = ((2 * k + j / GX) << 3) | (c & 7); slot = SL_P1E + (8 - GX) + j % GX;
    }
    int pm, pn;
    const char* x8 = (const char*)(ws + WS_X8); const unsigned row8 = D;
    if (slot < 6) {
        const int isK = slot >= 3, g = isK ? slot - 3 : slot; ge::tile_of(c, 64, 4, pm, pn);
        u.A = x8 + (size_t)perm_tile_token0(g, pm) * row8; u.sA = row8 << (2 * g);
        u.B = win + (size_t)((isK ? 3072 : 0) + g * 1024 + pn * 256) * rowK; u.nt = D / 128;
        u.i0 = __float_as_int(isK ? 1.0f : QSCALE);
        u.out = (char*)ws + (isK ? WS_KA : WS_QA) + (size_t)g * ((size_t)M * 1024 * 2) + ((size_t)pm * 256 * 1024 + pn * 256) * 2; u.ldo = 1024 * 2;
    } else if (slot < 9) {
        const int g = slot - 6; ge::tile_of(c, 4, 64, pm, pn);
        u.A = win + (size_t)(6144 + g * 1024 + pm * 256) * rowK;
        u.B = x8 + (size_t)perm_tile_token0(g, pn) * row8; u.sB = row8 << (2 * g); u.nt = D / 128;
        u.out = (char*)ws + WS_VTG + (size_t)g * ((size_t)1024 * M * 2) + ((size_t)pm * 256 * M + pn * 256) * 2; u.ldo = M * 2;
    } else if (slot < 13) {
        ge::tile_of((slot - 9) * 256 + c, 16, 64, pm, pn);
        u.A = win + (size_t)(13312 + pm * 256) * rowK; u.B = xb + (size_t)pn * 256 * rowK;
        u.out = (char*)ws + WS_VTR + ((size_t)pm * 256 * M + pn * 256) * 2; u.ldo = M * 2;
    } else if (slot < 17) {
        const int isK = slot >= 15; ge::tile_of((slot - (isK ? 15 : 13)) * 256 + c, 64, 8, pm, pn);
        u.A = xb + (size_t)pm * 256 * rowK; u.B = win + (size_t)((isK ? 11264 : 9216) + pn * 256) * rowK;
        u.i0 = (pm * 256) & (SEQ - 1); u.i1 = __float_as_int(isK ? 0.0625f : 1.0f);
        u.out = (char*)ws + (isK ? WS_KR : WS_QR) + ((size_t)pm * 256 * 2048 + pn * 256) * 2; u.ldo = 2048 * 2;
    } else if (slot < 19) {
        ge::tile_of((slot - 17) * 256 + c, 8, 64, pm, pn);
        u.A = win + (size_t)(11264 + pm * 256) * rowK; u.B = xb + (size_t)pn * 256 * rowK;
        u.i0 = (pn * 256) & (SEQ - 1); u.i1 = pm;
        u.out = (char*)ws + WS_KPT + ((size_t)pm * 256 * M + pn * 256) * 2; u.ldo = M * 2;
    } else if (slot < 31) {
        const int sgm = (slot - 19) >> 2; ge::tile_of(((slot - 19) & 3) * 256 + c, 64, 16, pm, pn);
        u.A = xb + (size_t)pm * 256 * rowK; u.B = win + (size_t)(17408 + sgm * 4096 + pn * 256) * rowK;
        if (sgm != 0) { u.A = x8 + (size_t)pm * 256 * row8; u.sA = row8; u.nt = D / 128; u.B = (const char*)ws + WS_WG8 + (size_t)((sgm - 1) * 4096 + pn * 256) * row8; u.sB = row8; }
        u.out = (char*)ws + (sgm == 0 ? WS_GR : (sgm == 1 ? WS_GA : WS_GRT)) + ((size_t)pm * 256 * D + pn * 256) * 2; u.ldo = D * 2;
    } else if (slot < 35) {
        ge::tile_of((slot - 31) * 256 + c, 64, 16, pm, pn);
        u.A = (const char*)ws + WS_PB + (size_t)pm * 256 * PLE * 2; u.sA = PLE * 2; u.B = (const char*)ws + WS_WPU + (size_t)pn * 256 * PLE * 2; u.sB = PLE * 2; u.nt = PLE / 64;
        u.out = (char*)ws + WS_T + ((size_t)pm * 256 * D + pn * 256) * 2; u.ldo = D * 2;
    } else if (slot < 43) {
        const int j = slot - 35, part = j & 1; ge::tile_of((j >> 1) * 256 + c, 64, 16, pm, pn);
        const size_t go = ((size_t)pm * 256 * D + pn * 256) * 2;
        u.x0 = (const char*)ws + WS_GA + go; u.x1 = (const char*)ws + WS_GRT + go; u.ldx = D * 2; u.out = (char*)ws + WS_MIX + go; u.ldo = D * 2;
        if (part == 0) { u.A = (const char*)ws + WS_OATT + (size_t)pm * 256 * 1024 * 2; u.sA = 1024 * 2; u.B = (const char*)ws + WS_WAO + (size_t)pn * 256 * 1024 * 2; u.sB = 1024 * 2; u.nt = 1024 / 64; }
        else           { u.A = (const char*)ws + WS_RG + (size_t)pm * 256 * D * 2; u.B = (const char*)ws + WS_WRO + (size_t)pn * 256 * D * 2; }
    } else if (slot < 47) {
        ge::tile_of((slot - 43) * 256 + c, 64, 16, pm, pn);
        u.A = (const char*)ws + WS_MIX + (size_t)pm * 256 * D * 2; u.B = (const char*)ws + WS_WO + (size_t)pn * 256 * D * 2;
        u.i0 = __float_as_int(ALPHA); const size_t fo = ((size_t)pm * 256 * D + pn * 256) * 4;
        u.x0 = (const char*)x + fo; u.ldx = D * 4; u.out = (char*)outp + fo; u.ldo = D * 4;
    } else if (slot < 69) {
        const int L = (slot - 47) * 256 + c;
        if (L >= 64 * 86) { u.nt = 0; return; }
        ge::tile_of(L, 64, 86, pm, pn);
        u.A = (const char*)ws + WS_H1B + (size_t)pm * 256 * D * 2; u.B = (const char*)ws + WS_WGU + (size_t)pn * 256 * D * 2;
        u.out = (char*)ws + WS_HID + ((size_t)pm * 256 * FF + pn * 128) * 2; u.ldo = FF * 2;
    } else if (slot < 74) {
        const int j = slot - 69;
        if (j >= 3 && c < 128) { u.nt = 0; return; }
        ge::tile_of(j < 3 ? j * 256 + c : 768 + (j - 3) * 128 + (c - 128), 64, 16, pm, pn);
        u.A = x8 + (size_t)pm * 256 * row8; u.sA = row8; u.nt = D / 128; u.B = (const char*)ws + WS_WPG + (size_t)pn * 256 * D * 2;
        u.x0 = (const char*)ws + WS_T + ((size_t)pm * 256 * D + pn * 256) * 2; u.ldx = D * 2;
        u.out = (char*)ws + WS_T + ((size_t)pm * 256 * D + pn * 256) * 2; u.ldo = D * 2;
    } else if (slot < 78) {
        ge::tile_of((slot - 74) * 256 + c, 64, 16, pm, pn);
        u.A = (const char*)ws + WS_HID + (size_t)pm * 256 * FF * 2; u.sA = FF * 2; u.B = (const char*)ws + WS_WD + (size_t)pn * 256 * FF * 2; u.sB = FF * 2; u.nt = FF / 64;
        if (!((slot - 74) & 1)) { u.A += (size_t)(FF / 64 - 1) * 128; u.B += (size_t)(FF / 64 - 1) * 128; }
        u.i0 = pm * 256; u.i1 = pn * 256; const size_t fo = ((size_t)pm * 256 * D + pn * 256) * 4;
        u.x0 = (const char*)ws + WS_STAT; u.x1 = (const char*)ws + WS_T + fo / 2; u.ldx = D * 2; u.out = (char*)outp + fo; u.ldo = D * 4;
    } else {
        if (c >= 64) { u.nt = 0; return; }
        const int n = slot - 78, b = c >> 4, h = (c >> 1) & 7, eh = c & 1;
        u.A = (const char*)ws + WS_VTR + ((size_t)(h * 512 + eh * 256) * M + b * SEQ + n * 128) * 2; u.sA = M * 2;
        u.B = (const char*)ws + WS_KPT + ((size_t)(h * 256) * M + b * SEQ + n * 128) * 2; u.sB = M * 2; u.nt = 2;
        u.out = (char*)ws + WS_ST + ((size_t)((b * 8 + h) * 32 + n + 1) * 512 + eh * 256) * 256 * 2; u.ldo = 256 * 2;
        u.i0 = __float_as_int(1.0f); u.i1 = __float_as_int(exp2f(128.0f * LOG2G[h]));
    }
}

__device__ __forceinline__ void p0_transpose_item(const float* W, int K, int N, bf16* WT, int mode, LAS float* scr, int item, int lane) {
    const int nblk = N / 32, kb = item / nblk, nb = item % nblk, k0 = 64 * kb, n0 = 32 * nb;
    { f32x4 v[8]; const int c4 = 4 * (lane & 7);
#pragma unroll
      for (int i = 0; i < 8; ++i) v[i] = *(const GAS f32x4*)(W + (size_t)(k0 + 8 * i + (lane >> 3)) * N + n0 + c4);
#pragma unroll
      for (int i = 0; i < 8; ++i) { LAS float* d = scr + (8 * i + (lane >> 3)) * 33 + c4; d[0] = v[i][0]; d[1] = v[i][1]; d[2] = v[i][2]; d[3] = v[i][3]; } }
    LDS_WAIT(); asm volatile("" ::: "memory");
    const int c = lane & 7;
    const int nbase = (mode == 0 || mode >= 3) ? n0 : ((n0 >> 7) * 256 + (n0 & 127) + (mode == 2 ? 128 : 0));
#pragma unroll
    for (int j = 0; j < 4; ++j) { const int n = (lane >> 3) + 8 * j; const LAS float* s = scr + (8 * c) * 33 + n;
        if (mode >= 3) { u32x2 o8; o8.x = pk_fp8x4(64.f * s[0 * 33], 64.f * s[1 * 33], 64.f * s[2 * 33], 64.f * s[3 * 33]); o8.y = pk_fp8x4(64.f * s[4 * 33], 64.f * s[5 * 33], 64.f * s[6 * 33], 64.f * s[7 * 33]);
            *(GAS u32x2*)((char*)WT + (size_t)(nbase + n) * (mode == 3 ? K * 2 : K) + k0 + 8 * c) = o8; continue; }
        u32x4 o; o.x = cvtpk(s[0 * 33], s[1 * 33]); o.y = cvtpk(s[2 * 33], s[3 * 33]); o.z = cvtpk(s[4 * 33], s[5 * 33]); o.w = cvtpk(s[6 * 33], s[7 * 33]);
        *(GAS u32x4*)(WT + (size_t)(nbase + n) * K + k0 + 8 * c) = o; }
    LDS_WAIT(); asm volatile("" ::: "memory");
}
constexpr int I_IN = (D / 64) * (NIN / 32), I_AO = (1024 / 64) * (D / 32), I_SQ = (D / 64) * (D / 32), I_FF = (D / 64) * (FF / 32), I_DN = (FF / 64) * (D / 32), I_PU = (PLE / 64) * (D / 32);
constexpr int N_LATE = I_AO + 3 * I_SQ + 2 * I_FF + I_DN + I_PU;
__device__ __forceinline__ void late_weight_item(const Args& a, unsigned char* ws, LAS float* scr, int r, int lane) {
    if (r < I_AO) { p0_transpose_item(a.in[3], 1024, D, (bf16*)(ws + WS_WAO), 0, scr, r, lane); return; } r -= I_AO;
    if (r < I_SQ) { p0_transpose_item(a.in[4], D, D, (bf16*)(ws + WS_WRO), 0, scr, r, lane); return; } r -= I_SQ;
    if (r < I_SQ) { p0_transpose_item(a.in[6], D, D, (bf16*)(ws + WS_WO), 0, scr, r, lane); return; } r -= I_SQ;
    if (r < I_FF) { p0_transpose_item(a.in[9], D, FF, (bf16*)(ws + WS_WGU), 1, scr, r, lane); return; } r -= I_FF;
    if (r < I_FF) { p0_transpose_item(a.in[10], D, FF, (bf16*)(ws + WS_WGU), 2, scr, r, lane); return; } r -= I_FF;
    if (r < I_DN) { p0_transpose_item(a.in[11], FF, D, (bf16*)(ws + WS_WD), 0, scr, r, lane); return; } r -= I_DN;
    if (r < I_SQ) { p0_transpose_item(a.in[12], D, D, (bf16*)(ws + WS_WPG), 3, scr, r, lane); return; } r -= I_SQ;
    p0_transpose_item(a.in[13], PLE, D, (bf16*)(ws + WS_WPU), 0, scr, r, lane);
}
__device__ __forceinline__ void late_weights_queue(Frame& F, const Args& a, int cw) {
    LAS float* scr = (LAS float*)(F.lds + F.wave * 16384);
    unsigned cur = 0u, end = 0u;
    for (;;) {
        const int lane = lane_now();
        if (cur == end) { unsigned idx = 0;
            if (lane == 0) idx = __hip_atomic_fetch_add((unsigned*)(F.ctl + cw), 64u, RLX_AGENT);
            idx = (unsigned)__builtin_amdgcn_readfirstlane((int)idx);
            if (idx >= (unsigned)N_LATE) break;
            cur = idx; end = idx + 64u < (unsigned)N_LATE ? idx + 64u : (unsigned)N_LATE; }
        late_weight_item(a, F.ws, scr, (int)cur, lane); ++cur;
    }
}
__device__ __forceinline__ void p0_prologue(Frame& F, const Args& a) {
    const int lane = lane_now(), tid = F.wave * 64 + lane;
    if (tid < NSLOT) { ge::GU u; make_unit(tid, F.c, F.ws, a.in[0], a.out, u);
        GAS unsigned* dst = (GAS unsigned*)(F.ws + WS_TAB) + ((size_t)F.c * NSLOT + tid) * ge::GU_DW; const unsigned* src = (const unsigned*)&u;
#pragma unroll
        for (int k = 0; k < ge::GU_DW; ++k) dst[k] = src[k]; }
    LAS float* scr = (LAS float*)(F.lds + F.wave * 16384);
    const int gw = F.c * NWAVES + F.wave, NGW = F.G * NWAVES;
    unsigned char* ws = F.ws;
    for (int it = gw; it < I_IN; it += NGW) { const int n0 = 32 * (it % (NIN / 32));
        if (n0 >= 21504) p0_transpose_item(a.in[2], D, NIN, (bf16*)(ws + WS_WG8 - (size_t)21504 * D), 4, scr, it, lane);
        else p0_transpose_item(a.in[2], D, NIN, (bf16*)(ws + WS_WIN), n0 < 9216 ? 3 : 0, scr, it, lane); }
    const size_t gt = (size_t)F.c * 512 + tid, NT = (size_t)F.G * 512;
    { const GAS f32x4* src = (const GAS f32x4*)a.in[0]; GAS u32x4* dst = (GAS u32x4*)(ws + WS_XB);
      GAS u32x2* dst8 = (GAS u32x2*)(ws + WS_X8);
      for (size_t i = gt; i < (size_t)M * D / 8; i += NT) { const f32x4 v0 = src[2 * i], v1 = src[2 * i + 1]; dst[i] = ge::pack8(v0, v1);
          u32x2 w8; w8.x = pk_fp8x4(v0[0], v0[1], v0[2], v0[3]); w8.y = pk_fp8x4(v1[0], v1[1], v1[2], v1[3]); dst8[i] = w8; } }
    { const GAS f32x4* src = (const GAS f32x4*)a.in[1]; GAS u32x4* dst = (GAS u32x4*)(ws + WS_PB);
      for (size_t i = gt; i < (size_t)M * PLE / 8; i += NT) { const f32x4 v0 = src[2 * i], v1 = src[2 * i + 1]; dst[i] = ge::pack8(v0, v1); } }
}

#define MFMA32(a, b, c) __builtin_amdgcn_mfma_f32_32x32x16_bf16((a), (b), (c), 0, 0, 0)
__device__ __forceinline__ bf16x8 ldg8(const bf16* p) { return *(const GAS bf16x8*)p; }
__device__ __forceinline__ bf16x8 pack_frag(const f32x16& x, int s) {
    u32x4 p; p.x = cvtpk(x[8 * s + 0], x[8 * s + 1]); p.y = cvtpk(x[8 * s + 2], x[8 * s + 3]); p.z = cvtpk(x[8 * s + 4], x[8 * s + 5]); p.w = cvtpk(x[8 * s + 6], x[8 * s + 7]);
    return __builtin_bit_cast(bf16x8, p);
}
__device__ __forceinline__ f32x16 zero16() { f32x16 z;
#pragma unroll
    for (int i = 0; i < 16; ++i) z[i] = 0.f; return z; }

__device__ __forceinline__ void attn_wg_item(int item, unsigned char* ws, LAS unsigned char* lds, int w, int lane) {
    const int g = item >> 9, rem = item & 511, head = rem >> 6, qb = rem & 63;
    const int L = SEQ >> (2 * g), prow0 = qb * 256, q0 = prow0 & (L - 1), r32 = lane & 31, hh = lane >> 5;
    const bf16* Q = (const bf16*)(ws + WS_QA) + (size_t)g * M * 1024 + head * 128 + 8 * hh;
    const bf16* Kg = (const bf16*)(ws + WS_KA) + (size_t)g * M * 1024 + head * 128;
    const bf16* VTg = (const bf16*)(ws + WS_VTG) + (size_t)g * 1024 * M + (size_t)(head * 128) * M;
#define AW_ISSUE(p) do { LAS unsigned char* bufp_ = lds + ((p) & 1) * 65536; const int krow_ = prow0 - 128 + 128 * (p); _Pragma("unroll") for (int i_ = 0; i_ < 4; ++i_) { \
        const int row_ = 4 * (4 * w + i_) + (lane >> 4), pc_ = (lane & 15) ^ (row_ & 15); \
        __builtin_amdgcn_global_load_lds((const unsigned*)(Kg + (size_t)(krow_ + row_) * 1024 + pc_ * 8), (LAS unsigned*)(bufp_ + (4 * w + i_) * 1024), 16, 0, 0); \
        __builtin_amdgcn_global_load_lds((const unsigned*)(VTg + (size_t)row_ * M + krow_ + pc_ * 8), (LAS unsigned*)(bufp_ + 32768 + (4 * w + i_) * 1024), 16, 0, 0); } } while (0)
    const int p0 = q0 >= 128 ? 0 : 1;
    bf16x8 qf[8];
#pragma unroll
    for (int kb = 0; kb < 8; ++kb) qf[kb] = ldg8(Q + (size_t)(prow0 + 32 * w + r32) * 1024 + kb * 16);
    AW_ISSUE(p0);
    f32x16 o[4]; o[0] = zero16(); o[1] = zero16(); o[2] = zero16(); o[3] = zero16();
    float mrun = -1e30f, lrun = 0.f;
    const int kperm = (r32 & ~12) | ((r32 & 4) << 1) | ((r32 & 8) >> 1);
    for (int p = p0; p < 3; ++p) {
        VM_WAIT(); __syncthreads();
        if (p < 2) AW_ISSUE(p + 1);
        asm volatile("" ::: "memory"); __builtin_amdgcn_sched_barrier(0);
        const LAS unsigned char* kb_ = lds + (p & 1) * 65536; const LAS unsigned char* vb_ = kb_ + 32768;
        const int ch_lo = 4 * p > w ? 4 * p : w, ch_hi = 4 * p + 4 < w + 5 ? 4 * p + 4 : w + 5;
        for (int ch = ch_lo; ch < ch_hi; ++ch) {
            const int c = ch - w, cl = ch - 4 * p;
            if (q0 + 32 * w - 128 + 32 * c < 0) continue;
            bf16x8 kf[8];
            { const int krow = cl * 32 + kperm; const LAS unsigned char* kr = kb_ + krow * 256; const int kx = krow & 15;
#pragma unroll
              for (int kb = 0; kb < 8; ++kb) kf[kb] = *(const LAS bf16x8*)(kr + (((2 * kb + hh) ^ kx) << 4)); }
            f32x16 sa = zero16();
#pragma unroll
            for (int kb = 0; kb < 8; ++kb) sa = MFMA32(kf[kb], qf[kb], sa);
            float cm = -1e30f;
#pragma unroll
            for (int i = 0; i < 16; ++i) { const int kap = (i & 7) + 8 * hh + 16 * (i >> 3);
                const bool valid = !((c == 0 && kap < r32) || (c == 4 && kap > r32));
                sa[i] = valid ? sa[i] : -1e30f; cm = fmaxf(cm, sa[i]); }
            cm = fmaxf(cm, __shfl_xor(cm, 32));
            const float mnew = fmaxf(mrun, cm), alpha = fexp2(mrun - mnew);
            float ps = 0.f;
#pragma unroll
            for (int i = 0; i < 16; ++i) { sa[i] = fexp2(sa[i] - mnew); ps += sa[i]; }
            ps += __shfl_xor(ps, 32);
            lrun = lrun * alpha + ps; mrun = mnew;
            const bf16x8 pf0 = pack_frag(sa, 0), pf1 = pack_frag(sa, 1);
            bf16x8 vf[4][2];
#pragma unroll
            for (int eb = 0; eb < 4; ++eb)
#pragma unroll
                for (int s2 = 0; s2 < 2; ++s2) { const int row = eb * 32 + r32; vf[eb][s2] = *(const LAS bf16x8*)(vb_ + row * 256 + (((4 * cl + 2 * s2 + hh) ^ (row & 15)) << 4)); }
#pragma unroll
            for (int eb = 0; eb < 4; ++eb) { o[eb] = o[eb] * alpha; o[eb] = MFMA32(vf[eb][0], pf0, o[eb]); o[eb] = MFMA32(vf[eb][1], pf1, o[eb]); }
        }
    }
    __syncthreads();
    LAS unsigned char* wl = lds + 65536 + w * 8192;
    const float inv = 1.0f / lrun;
#pragma unroll
    for (int eb = 0; eb < 4; ++eb)
#pragma unroll
        for (int a = 0; a < 4; ++a) { u32x2 wv; wv.x = cvtpk(o[eb][4 * a] * inv, o[eb][4 * a + 1] * inv); wv.y = cvtpk(o[eb][4 * a + 2] * inv, o[eb][4 * a + 3] * inv);
            *(LAS u32x2*)(wl + r32 * 256 + (((eb * 4 + a) ^ (r32 & 15)) << 4) + 8 * hh) = wv; }
    LDS_WAIT();
    bf16* OG = (bf16*)(ws + WS_OG) + (size_t)g * M * 1024 + (size_t)(prow0 + 32 * w) * 1024 + head * 128;
#pragma unroll
    for (int j = 0; j < 8; ++j) { const int row = 4 * j + (lane >> 4), pc = (lane & 15) ^ (row & 15);
        const u32x4 v = *(const LAS u32x4*)(wl + row * 256 + ((lane & 15) << 4)); *(GAS u32x4*)(OG + (size_t)row * 1024 + pc * 8) = v; }
    if (hh == 0) ((GAS float*)(ws + WS_LSE))[(size_t)g * M * 8 + (size_t)(prow0 + 32 * w + r32) * 8 + head] = mrun + __builtin_amdgcn_logf(lrun);
    LDS_WAIT(); __syncthreads();
#undef AW_ISSUE
}
__device__ __forceinline__ void p2a_attention(Frame& F, int cw) {
    volatile LAS unsigned* slot = (volatile LAS unsigned*)(F.lds + MISC_OFF + 64);
    for (;;) {
        const int lane = lane_now();
        if (F.wave == 0 && lane == 0) *slot = __hip_atomic_fetch_add((unsigned*)(F.ctl + cw), 1u, RLX_AGENT);
        __syncthreads();
        const unsigned idx = (unsigned)__builtin_amdgcn_readfirstlane((int)*slot);
        __syncthreads();
        if (idx >= 1536u) break;
        attn_wg_item((int)idx, F.ws, F.lds, F.wave, lane);
    }
}

__device__ __forceinline__ void ret_unit(Frame& F, int unit, const float* gn_g) {
    const int b = unit >> 8, h = (unit >> 5) & 7, n = unit & 31, lane = lane_now(), w = F.wave, r32 = lane & 31, hh = lane >> 5;
    unsigned char* ws = F.ws;
    const int tok0 = b * SEQ + n * 128;
    const float lg = LOG2G[h];
    const bf16* QRg = (const bf16*)(ws + WS_QR) + (size_t)tok0 * 2048 + h * 256;
    const bf16* KR = (const bf16*)(ws + WS_KR) + (size_t)tok0 * 2048 + h * 256 + 8 * hh;
    LAS unsigned char* fr = F.lds;
    LAS float* stt = (LAS float*)(F.lds + 20480);
    LAS unsigned char* ql = F.lds + 32768;
    const int kperm = (r32 & ~12) | ((r32 & 4) << 1) | ((r32 & 8) >> 1);
#pragma unroll
    for (int i = 0; i < 8; ++i) { const int row = 2 * (w * 8 + i) + hh, pc = r32 ^ (row & 15);
        __builtin_amdgcn_global_load_lds((const unsigned*)(QRg + (size_t)row * 2048 + pc * 8), (LAS unsigned*)(ql + (w * 8 + i) * 1024), 16, 0, 0); }
    VM_WAIT(); __syncthreads();
#define RU_QFRAG(qb, ks) (*(const LAS bf16x8*)(ql + ((qb) * 32 + r32) * 512 + ((((2 * (ks) + hh)) ^ (r32 & 15)) << 4)))
    for (int k = w; k < 10; k += 8) {
        const int jb = k < 4 ? 0 : (k < 7 ? 1 : (k < 9 ? 2 : 3)), qb = k < 4 ? k : (k < 7 ? k - 3 : (k < 9 ? k - 5 : 3));
        f32x16 x = zero16();
        const bf16* ka = KR + (size_t)(jb * 32 + kperm) * 2048;
        bf16x8 kf[16];
#pragma unroll
        for (int ks = 0; ks < 16; ++ks) kf[ks] = ldg8(ka + ks * 16);
#pragma unroll
        for (int ks = 0; ks < 16; ++ks) x = MFMA32(kf[ks], RU_QFRAG(qb, ks), x);
#pragma unroll
        for (int i = 0; i < 16; ++i) { const int j = jb * 32 + (i & 7) + 8 * hh + 16 * (i >> 3), q = qb * 32 + r32, df = q - j; x[i] = df >= 0 ? x[i] * fexp2((float)df * lg) : 0.f; }
        *(LAS bf16x8*)(fr + ((k * 2 + 0) * 64 + lane) * 16) = pack_frag(x, 0);
        *(LAS bf16x8*)(fr + ((k * 2 + 1) * 64 + lane) * 16) = pack_frag(x, 1);
    }
    __syncthreads();
    f32x16 acc[2][4];
#pragma unroll
    for (int e2 = 0; e2 < 2; ++e2)
#pragma unroll
        for (int qb = 0; qb < 4; ++qb) acc[e2][qb] = zero16();
    if (n > 0) {
        const bf16* ST = (const bf16*)(ws + WS_ST) + ((size_t)(((b * 8 + h) * 32 + n)) * 512 + w * 64 + r32) * 256 + 8 * hh;
        bf16x8 sa[2][4][2];
#pragma unroll
        for (int j = 0; j < 4; ++j) { sa[0][j][0] = ldg8(ST + j * 16); sa[0][j][1] = ldg8(ST + (size_t)32 * 256 + j * 16); }
#pragma unroll
        for (int kb = 0; kb < 4; ++kb) {
            if (kb < 3) {
#pragma unroll
                for (int j = 0; j < 4; ++j) { sa[(kb + 1) & 1][j][0] = ldg8(ST + ((kb + 1) * 4 + j) * 16); sa[(kb + 1) & 1][j][1] = ldg8(ST + (size_t)32 * 256 + ((kb + 1) * 4 + j) * 16); } }
#pragma unroll
            for (int j = 0; j < 4; ++j) { const int ks = kb * 4 + j;
#pragma unroll
                for (int qb = 0; qb < 4; ++qb) { const bf16x8 bq = RU_QFRAG(qb, ks); acc[0][qb] = MFMA32(sa[kb & 1][j][0], bq, acc[0][qb]); acc[1][qb] = MFMA32(sa[kb & 1][j][1], bq, acc[1][qb]); } }
        }
#pragma unroll
        for (int qb = 0; qb < 4; ++qb) { const float sc = fexp2((float)(qb * 32 + r32 + 1) * lg); acc[0][qb] = acc[0][qb] * sc; acc[1][qb] = acc[1][qb] * sc; }
    }
    {
        const bf16* VT = (const bf16*)(ws + WS_VTR) + (size_t)(h * 512 + w * 64 + r32) * M + tok0 + 8 * hh;
#pragma unroll
        for (int jb = 0; jb < 4; ++jb)
#pragma unroll
            for (int s = 0; s < 2; ++s) {
                const bf16x8 a0 = ldg8(VT + jb * 32 + 16 * s), a1 = ldg8(VT + (size_t)32 * M + jb * 32 + 16 * s);
#pragma unroll
                for (int qb = jb; qb < 4; ++qb) { const int k = (jb == 0 ? 0 : (jb == 1 ? 4 : (jb == 2 ? 7 : 9))) + (qb - jb);
                    const bf16x8 p = *(const LAS bf16x8*)(fr + ((k * 2 + s) * 64 + lane) * 16);
                    acc[0][qb] = MFMA32(a0, p, acc[0][qb]); acc[1][qb] = MFMA32(a1, p, acc[1][qb]); }
            }
    }
#pragma unroll
    for (int qb = 0; qb < 4; ++qb) { float s1 = 0.f, s2 = 0.f;
#pragma unroll
        for (int e2 = 0; e2 < 2; ++e2)
#pragma unroll
            for (int i = 0; i < 16; ++i) { const float v = acc[e2][qb][i]; s1 += v; s2 += v * v; }
        s1 += __shfl_xor(s1, 32); s2 += __shfl_xor(s2, 32);
        if (hh == 0) { stt[((qb * 32 + r32) * 8 + w) * 2] = s1; stt[((qb * 32 + r32) * 8 + w) * 2 + 1] = s2; } }
    __syncthreads();
    const float* gp = gn_g + h * 512 + w * 64 + 4 * hh;
#pragma unroll
    for (int qb = 0; qb < 4; ++qb) { float s1 = 0.f, s2 = 0.f;
#pragma unroll
        for (int ww = 0; ww < 8; ++ww) { s1 += stt[((qb * 32 + r32) * 8 + ww) * 2]; s2 += stt[((qb * 32 + r32) * 8 + ww) * 2 + 1]; }
        const float mu = s1 * (1.0f / 512.0f), var = fmaxf(s2 * (1.0f / 512.0f) - mu * mu, 0.f), rstd = 1.0f / sqrtf(var + GN_EPS);
        const size_t ro = (size_t)(tok0 + qb * 32 + r32) * D + h * 512 + w * 64 + 4 * hh;
        const bf16* gr = (const bf16*)(ws + WS_GR) + ro; bf16* og = (bf16*)(ws + WS_RG) + ro;
#pragma unroll
        for (int e2 = 0; e2 < 2; ++e2)
#pragma unroll
            for (int a = 0; a < 4; ++a) { const f32x4 gg = *(const GAS f32x4*)(gp + e2 * 32 + 8 * a); const u32x2 sg = *(const GAS u32x2*)(gr + e2 * 32 + 8 * a);
                const float v0 = (acc[e2][qb][4 * a] - mu) * rstd * gg[0] * bflo(sg.x), v1 = (acc[e2][qb][4 * a + 1] - mu) * rstd * gg[1] * bfhi(sg.x);
                const float v2 = (acc[e2][qb][4 * a + 2] - mu) * rstd * gg[2] * bflo(sg.y), v3 = (acc[e2][qb][4 * a + 3] - mu) * rstd * gg[3] * bfhi(sg.y);
                u32x2 wv; wv.x = cvtpk(v0, v1); wv.y = cvtpk(v2, v3); *(GAS u32x2*)(og + e2 * 32 + 8 * a) = wv; } }
    __syncthreads();
}
#undef RU_QFRAG
__device__ __forceinline__ void combine_token(unsigned char* ws, int t, int lane) {
    const int b = t >> 12, sp = t & (SEQ - 1), head = lane >> 3;
    float lse[3]; size_t prow[3];
#pragma unroll
    for (int g = 0; g < 3; ++g) { const int sh = 2 * g, d = 1 << sh, L = SEQ >> sh; prow[g] = (size_t)(b * d + (sp & (d - 1))) * L + (sp >> sh);
        lse[g] = ((const GAS float*)(ws + WS_LSE))[(size_t)g * M * 8 + prow[g] * 8 + head]; }
    const float mx = fmaxf(lse[0], fmaxf(lse[1], lse[2]));
    float wg[3], ws_ = 0.f;
#pragma unroll
    for (int g = 0; g < 3; ++g) { wg[g] = fexp2(lse[g] - mx); ws_ += wg[g]; }
    const float inv = 1.0f / ws_;
    f32x4 o[4];
#pragma unroll
    for (int j = 0; j < 4; ++j) o[j] = (f32x4){0.f, 0.f, 0.f, 0.f};
#pragma unroll
    for (int g = 0; g < 3; ++g) { const bf16* og = (const bf16*)(ws + WS_OG) + (size_t)g * M * 1024 + prow[g] * 1024 + lane * 16;
        const u32x4 w0 = *(const GAS u32x4*)og, w1 = *(const GAS u32x4*)(og + 8); f32x4 a0, a1, a2, a3; ge::unpack8(w0, a0, a1); ge::unpack8(w1, a2, a3);
        const float f = wg[g] * inv; o[0] += a0 * f; o[1] += a1 * f; o[2] += a2 * f; o[3] += a3 * f; }
    bf16* oa = (bf16*)(ws + WS_OATT) + (size_t)t * 1024 + lane * 16;
    *(GAS u32x4*)oa = ge::pack8(o[0], o[1]); *(GAS u32x4*)(oa + 8) = ge::pack8(o[2], o[3]);
}
__device__ __forceinline__ void p2b_phase(Frame& F, const float* gn_g) {
    for (int u = F.c; u < 1024; u += F.G) ret_unit(F, u, gn_g);
    const int gw = F.c * NWAVES + F.wave, NGW = F.G * NWAVES;
    { const int lane = lane_now(); for (int t = gw; t < M; t += NGW) combine_token(F.ws, t, lane); }
}

__device__ __forceinline__ void ln2_rows(Frame& F, const bf16* src, float* dst, const float* gam, const float* bet) {
    const int gw = F.c * NWAVES + F.wave, NGW = F.G * NWAVES, lane = lane_now();
    for (int m = gw; m < M; m += NGW) {
        const GAS u32x4* xr = (const GAS u32x4*)(src + (size_t)m * D) + lane;
        f32x4 v[16]; float s = 0.f;
#pragma unroll
        for (int j = 0; j < 8; ++j) { const u32x4 w = xr[64 * j]; ge::unpack8(w, v[2 * j], v[2 * j + 1]);
            s += ((v[2 * j][0] + v[2 * j][1]) + (v[2 * j][2] + v[2 * j][3])) + ((v[2 * j + 1][0] + v[2 * j + 1][1]) + (v[2 * j + 1][2] + v[2 * j + 1][3])); }
        const float mean = wave_sum(s) * (1.0f / D); float s2 = 0.f;
#pragma unroll
        for (int j = 0; j < 16; ++j) { v[j] = v[j] - mean; s2 += (v[j][0] * v[j][0] + v[j][1] * v[j][1]) + (v[j][2] * v[j][2] + v[j][3] * v[j][3]); }
        const float rstd = 1.0f / sqrtf(wave_sum(s2) * (1.0f / D) + LN_EPS);
        GAS f32x4* of = (GAS f32x4*)(dst + (size_t)m * D) + 2 * lane;
#pragma unroll
        for (int j = 0; j < 8; ++j) { const GAS f32x4* gp = (const GAS f32x4*)gam + 2 * (lane + 64 * j); const GAS f32x4* bp = (const GAS f32x4*)bet + 2 * (lane + 64 * j);
            of[128 * j] = v[2 * j] * rstd * gp[0] + bp[0]; of[128 * j + 1] = v[2 * j + 1] * rstd * gp[1] + bp[1]; }
    }
}
template <int MODE>
__device__ __forceinline__ void ln_rows(Frame& F, const float* src, float* dstf, bf16* dstb, unsigned char* dst8, float* stat, const float* gam, const float* bet) {
    const int gw = F.c * NWAVES + F.wave, NGW = F.G * NWAVES, lane = lane_now();
    if (MODE == 1 && gw < D / 64) { const int col = gw * 64 + lane; ((GAS f32x2_t*)stat)[M + col] = (f32x2_t){ALPHA * gam[col], ALPHA * bet[col]}; }
    for (int m = gw; m < M; m += NGW) {
        const GAS f32x4* xr = (const GAS f32x4*)(src + (size_t)m * D) + lane;
        f32x4 v[16]; float s = 0.f;
#pragma unroll
        for (int j = 0; j < 16; ++j) { v[j] = xr[64 * j]; s += (v[j][0] + v[j][1]) + (v[j][2] + v[j][3]); }
        const float mean = wave_sum(s) * (1.0f / D); float s2 = 0.f;
#pragma unroll
        for (int j = 0; j < 16; ++j) { v[j] = v[j] - mean; s2 += (v[j][0] * v[j][0] + v[j][1] * v[j][1]) + (v[j][2] * v[j][2] + v[j][3] * v[j][3]); }
        const float rstd = 1.0f / sqrtf(wave_sum(s2) * (1.0f / D) + LN_EPS);
        if (MODE == 1 && lane == 0) ((GAS f32x2_t*)stat)[m] = (f32x2_t){mean, rstd};
        GAS f32x4* of = (GAS f32x4*)(dstf + (size_t)m * D) + lane;
        GAS u32x2* ob = (GAS u32x2*)(dstb + (size_t)m * D) + lane;
        GAS unsigned* o8 = (GAS unsigned*)(dst8 + (size_t)m * D) + lane;
#pragma unroll
        for (int j = 0; j < 16; ++j) { const f32x4 gg = *((const GAS f32x4*)gam + lane + 64 * j), bb = *((const GAS f32x4*)bet + lane + 64 * j);
            const f32x4 y = v[j] * rstd * gg + bb;
            if (MODE == 1) { u32x2 w; w.x = cvtpk(y[0], y[1]); w.y = cvtpk(y[2], y[3]); ob[64 * j] = w; o8[64 * j] = pk_fp8x4(y[0], y[1], y[2], y[3]); } else of[64 * j] = y; }
    }
}

__device__ __forceinline__ void kpt_transpose(Frame& F) {
    const int lane = lane_now(), gw = F.c * NWAVES + F.wave, NGW = F.G * NWAVES;
    LAS unsigned short* scr = (LAS unsigned short*)(F.lds + F.wave * 16384);
    const bf16* KR = (const bf16*)(F.ws + WS_KR); bf16* KT = (bf16*)(F.ws + WS_KPT);
    for (int it = gw; it < (M / 64) * (2048 / 64); it += NGW) {
        const int tb = it >> 5, fb = it & 31, tok0 = tb * 64, f0 = fb * 64, h = fb >> 2;
#pragma unroll
        for (int i = 0; i < 8; ++i) { const int r = 8 * i + (lane >> 3), cpos = (lane & 7) * 8;
            const u32x4 v = *(const GAS u32x4*)(KR + (size_t)(tok0 + r) * 2048 + f0 + cpos);
            LAS unsigned* d = (LAS unsigned*)(scr + r * 66 + cpos); d[0] = v.x; d[1] = v.y; d[2] = v.z; d[3] = v.w; }
        LDS_WAIT(); asm volatile("" ::: "memory");
        const float lg = LOG2G[h]; const int tpos = (lane & 7) * 8;
        float dec[8];
#pragma unroll
        for (int j = 0; j < 8; ++j) dec[j] = fexp2((float)(127 - ((tok0 + tpos + j) & 127)) * lg);
#pragma unroll
        for (int i = 0; i < 8; ++i) { const int f = 8 * i + (lane >> 3); float v[8];
#pragma unroll
            for (int j = 0; j < 8; ++j) v[j] = __uint_as_float((unsigned)scr[(tpos + j) * 66 + f] << 16) * dec[j];
            u32x4 o; o.x = cvtpk(v[0], v[1]); o.y = cvtpk(v[2], v[3]); o.z = cvtpk(v[4], v[5]); o.w = cvtpk(v[6], v[7]);
            *(GAS u32x4*)(KT + (size_t)(f0 + f) * M + tok0 + tpos) = o; }
        LDS_WAIT(); asm volatile("" ::: "memory");
    }
}

__global__ void __launch_bounds__(NWAVES * 64, 2) mk_fwd(Args args) {
    extern __shared__ __attribute__((aligned(16))) unsigned char lds[];
    Frame F;
    F.lds = (LAS unsigned char*)lds;
    F.wave = __builtin_amdgcn_readfirstlane((int)(threadIdx.x >> 6));
    F.G = gridDim.x; F.c = blockIdx.x; F.ws = args.ws;
    F.ctl = (gu32*)(args.ws + WS_CTL);
    volatile LAS unsigned* MISC = (volatile LAS unsigned*)(F.lds + MISC_OFF);
    for (int u = threadIdx.x; u < (LDS_BYTES - LDSCTL_OFF) / 4; u += NWAVES * 64) ((LAS unsigned*)(F.lds + LDSCTL_OFF))[u] = 0u;
    __syncthreads();
    XcdBarrier bar; bar.bar = (unsigned*)(F.ctl + CW_BAR); bar.x = 0; bar.st = nullptr; bar.wave = F.wave;
    if (MK_N_LAUNCHES == 1) bar = xcd_barrier_post((unsigned*)(F.ctl + CW_BAR), MISC + 8, F.wave);
    const int lo = args.ph_lo, hi = args.ph_hi;
#ifndef ST_MASK
#define ST_MASK 0xff
#endif
#define SM(k) ((ST_MASK >> (k)) & 1)
#ifndef DUP_MASK
#define DUP_MASK 0
#endif
#define DUP(k) ((DUP_MASK >> (k)) & 1)
#ifndef PH_MASK
#define PH_MASK 0x7ff
#endif
#define IN(k) (((PH_MASK >> (k)) & 1) && lo <= (k) && (k) < hi)
#define SEAM(k) do { if (IN(k) && IN((k) + 1)) xcd_barrier(bar); } while (0)

    if (IN(0)) { p0_prologue(F, args); if (DUP(0)) { xcd_barrier(bar); p0_prologue(F, args); } SEAM(0); }
    const unsigned* utab = (const unsigned*)(args.ws + WS_TAB) + (size_t)F.c * NSLOT * ge::GU_DW;
#define UT(slot) (utab + (slot) * ge::GU_DW)
    if (IN(1)) {
        ge::gemm_stream<ge::K_SCALE, 0, true>(F.lds, UT(SL_P1), 9, F.wave);
        ge::gemm_stream<ge::K_SCALE, 0>(F.lds, UT(SL_P1 + 9), 4, F.wave);
        ge::gemm_stream<ge::K_ROT, 0>(F.lds, UT(SL_P1B), 4, F.wave);
        ge::gemm_stream<ge::K_SILU, 0>(F.lds, UT(SL_P1D), 4, F.wave);
        ge::gemm_stream<ge::K_SIG, 0, true>(F.lds, UT(SL_P1E), 8 - GX, F.wave);
        if (DUP(1)) { xcd_barrier(bar); ge::gemm_stream<ge::K_SCALE, 0, true>(F.lds, UT(SL_P1), 9, F.wave); ge::gemm_stream<ge::K_SCALE, 0>(F.lds, UT(SL_P1 + 9), 4, F.wave); ge::gemm_stream<ge::K_ROT, 0>(F.lds, UT(SL_P1B), 4, F.wave); ge::gemm_stream<ge::K_SILU, 0>(F.lds, UT(SL_P1D), 4, F.wave); ge::gemm_stream<ge::K_SIG, 0, true>(F.lds, UT(SL_P1E), 8 - GX, F.wave); }
        SEAM(1); }
    if (IN(2)) { kpt_transpose(F); if (DUP(2)) { xcd_barrier(bar); kpt_transpose(F); } SEAM(2); }
    if (IN(3)) { ge::gemm_stream<ge::K_SCALE, 2>(F.lds, UT(SL_SCAN), 31, F.wave); ge::gemm_stream<ge::K_SIG, 0, true>(F.lds, UT(SL_G2), 2 * GX, F.wave); late_weights_queue(F, args, CW_WORK + 64); p2a_attention(F, CW_WORK); if (DUP(11)) { xcd_barrier(bar); p2a_attention(F, CW_WORK + 128); } if (DUP(12)) { xcd_barrier(bar); late_weights_queue(F, args, CW_WORK + 192); } if (DUP(3)) { xcd_barrier(bar); ge::gemm_stream<ge::K_SCALE, 2>(F.lds, UT(SL_SCAN), 31, F.wave); } SEAM(3); }
    if (IN(4)) { p2b_phase(F, args.in[5]); if (DUP(4)) { xcd_barrier(bar); p2b_phase(F, args.in[5]); } SEAM(4); }
    if (IN(5)) { ge::gemm_stream<ge::K_SCALE, 0>(F.lds, UT(SL_P3), 4, F.wave); ge::gemm_stream<ge::K_FIN, 1>(F.lds, UT(SL_P3B), 8, F.wave); if (DUP(5)) { xcd_barrier(bar); ge::gemm_stream<ge::K_SCALE, 0>(F.lds, UT(SL_P3), 4, F.wave); ge::gemm_stream<ge::K_FIN, 1>(F.lds, UT(SL_P3B), 8, F.wave); } SEAM(5); }
    if (IN(6)) { ge::gemm_stream<ge::K_WO, 0>(F.lds, UT(SL_P4), 4, F.wave); if (DUP(6)) { xcd_barrier(bar); ge::gemm_stream<ge::K_WO, 0>(F.lds, UT(SL_P4), 4, F.wave); } SEAM(6); }
    if (IN(7)) { ln_rows<1>(F, args.out, nullptr, (bf16*)(args.ws + WS_H1B), args.ws + WS_X8, (float*)(args.ws + WS_STAT), args.in[7], args.in[8]); if (DUP(7)) { xcd_barrier(bar); ln_rows<1>(F, args.out, nullptr, (bf16*)(args.ws + WS_H1B), args.ws + WS_X8, (float*)(args.ws + WS_STAT), args.in[7], args.in[8]); } SEAM(7); }
    if (IN(8)) { ge::gemm_stream<ge::K_SWIGLU, 0>(F.lds, UT(SL_P5), 22, F.wave); if (DUP(8)) { xcd_barrier(bar); ge::gemm_stream<ge::K_SWIGLU, 0>(F.lds, UT(SL_P5), 22, F.wave); } ge::gemm_stream<ge::K_PLE, 0, true>(F.lds, UT(SL_P5B), 5, F.wave); SEAM(8); }
    if (IN(9)) { ge::gemm_stream<ge::K_DOWN, 0, false, true>(F.lds, UT(SL_P6), 4, F.wave); if (DUP(9)) { xcd_barrier(bar); ge::gemm_stream<ge::K_DOWN, 0>(F.lds, UT(SL_P6), 4, F.wave); } SEAM(9); }
    if (IN(10)) { ln2_rows(F, (const bf16*)(args.ws + WS_P2B), args.out, args.in[14], args.in[15]); }
#undef IN
#undef SEAM
}

extern "C" void kernel_launch(void* const* d_in, const int* in_sizes, int n_in, void* d_out, int out_size, void* d_ws, size_t ws_size, hipStream_t stream) {
    static int grid = 0;
    if (grid == 0) {
        if (n_in != 16 || out_size != M * D || ws_size < WS_END) { fprintf(stderr, "kernel_launch: unexpected problem (n_in %d, out %d, ws %zu); nothing launched\n", n_in, out_size, ws_size); grid = -1; return; }
        int dev = 0, cus = 0;
        if (hipGetDevice(&dev) != hipSuccess || hipDeviceGetAttribute(&cus, hipDeviceAttributeMultiprocessorCount, dev) != hipSuccess) { grid = -1; return; }
        if (hipFuncSetAttribute((const void*)mk_fwd, hipFuncAttributeMaxDynamicSharedMemorySize, LDS_BYTES) != hipSuccess) { fprintf(stderr, "kernel_launch: hipFuncSetAttribute failed\n"); grid = -1; return; }
        int per_cu = 0;
        if (hipOccupancyMaxActiveBlocksPerMultiprocessor(&per_cu, (const void*)mk_fwd, NWAVES * 64, LDS_BYTES) != hipSuccess || per_cu < 1) fprintf(stderr, "kernel_launch: occupancy query reports %d\n", per_cu);
        (void)hipGetLastError();
        grid = cus;
        if (grid != 256) { fprintf(stderr, "kernel_launch: built for 256 CUs, device has %d\n", grid); }
    }
    if (grid < 0) return;
    (void)hipMemsetAsync((char*)d_ws + WS_CTL, 0, CTL_ZERO_BYTES, stream);
    Args a{};
    for (int i = 0; i < 16; ++i) a.in[i] = (const float*)d_in[i];
    a.out = (float*)d_out; a.ws = (unsigned char*)d_ws;
    if (MK_N_LAUNCHES == 1) { a.ph_lo = 0; a.ph_hi = N_PHASES; hipLaunchKernelGGL(mk_fwd, dim3(grid), dim3(NWAVES * 64), LDS_BYTES, stream, a); }
    else for (int p = 0; p < N_PHASES; ++p) { a.ph_lo = p; a.ph_hi = p + 1; hipLaunchKernelGGL(mk_fwd, dim3(grid), dim3(NWAVES * 64), LDS_BYTES, stream, a); }
}
```

```cpp
#include <hip/hip_runtime.h>
#include <cstdio>
#include <cstdint>

#ifndef MK_N_LAUNCHES
#define MK_N_LAUNCHES 1
#endif
constexpr int N_PHASES = 11;

#define GAS __attribute__((address_space(1)))
#define LAS __attribute__((address_space(3)))
typedef unsigned short bf16;
typedef short bf16x8 __attribute__((ext_vector_type(8)));
typedef float f32x4 __attribute__((ext_vector_type(4)));
typedef float f32x16 __attribute__((ext_vector_type(16)));
typedef unsigned u32x4 __attribute__((ext_vector_type(4)));
typedef unsigned u32x2 __attribute__((ext_vector_type(2)));
typedef __bf16 bf16x2_t __attribute__((ext_vector_type(2)));
typedef float f32x2_t __attribute__((ext_vector_type(2)));
typedef GAS unsigned gu32;
#define RLX_AGENT __ATOMIC_RELAXED, __HIP_MEMORY_SCOPE_AGENT
#define LDS_WAIT() asm volatile("s_waitcnt lgkmcnt(0)" ::: "memory")
#define VM_WAIT() asm volatile("s_waitcnt vmcnt(0)" ::: "memory")

constexpr int M = 16384, D = 4096, SEQ = 4096, PLE = 256, FF = 11008, NIN = 29696;
constexpr float ALPHA = 1.189207115002721f;
constexpr float QSCALE = 0.12751743082459868f;
constexpr float LN_EPS = 1e-5f, GN_EPS = 1e-6f;
__device__ const float LOG2G[8] = {-4.580368961312e-02f, -2.272007650008e-02f, -1.131531322783e-02f, -5.646563141142e-03f, -2.820519062379e-03f, -1.409570254671e-03f, -7.046129765894e-04f, -3.522634716290e-04f};
__device__ const float INVF[128] = {
1.000000000e+00f, 9.305720329e-01f, 8.659643531e-01f, 8.058421612e-01f, 7.498942614e-01f, 6.978306174e-01f, 6.493816376e-01f, 6.042963862e-01f, 5.623413324e-01f, 5.232990980e-01f, 4.869675338e-01f, 4.531583786e-01f, 4.216965139e-01f, 3.924189806e-01f, 3.651741147e-01f, 3.398208320e-01f, 3.162277639e-01f, 2.942726910e-01f, 2.738419771e-01f, 2.548296750e-01f, 2.371373773e-01f, 2.206734121e-01f, 2.053525001e-01f, 1.910953075e-01f, 1.778279394e-01f, 1.654817164e-01f, 1.539926529e-01f, 1.433012486e-01f, 1.333521307e-01f, 1.240937784e-01f, 1.154782027e-01f, 1.074607819e-01f, 1.000000015e-01f, 9.305720776e-02f, 8.659642935e-02f, 8.058421314e-02f, 7.498941571e-02f, 6.978306174e-02f, 6.493816525e-02f, 6.042964011e-02f, 5.623413250e-02f, 5.232991278e-02f, 4.869675264e-02f, 4.531583562e-02f, 4.216965288e-02f, 3.924189508e-02f, 3.651741147e-02f, 3.398208320e-02f, 3.162277490e-02f, 2.942727134e-02f, 2.738419734e-02f, 2.548296750e-02f, 2.371373773e-02f, 2.206734009e-02f, 2.053525113e-02f, 1.910952851e-02f, 1.778279431e-02f, 1.654816978e-02f, 1.539926510e-02f, 1.433012541e-02f, 1.333521493e-02f, 1.240937784e-02f, 1.154782064e-02f, 1.074607857e-02f, 9.999999776e-03f, 9.305720218e-03f, 8.659643121e-03f, 8.058422245e-03f, 7.498941850e-03f, 6.978305988e-03f, 6.493816152e-03f, 6.042963825e-03f, 5.623413250e-03f, 5.232991185e-03f, 4.869675264e-03f, 4.531583283e-03f, 4.216964822e-03f, 3.924189601e-03f, 3.651741194e-03f, 3.398208413e-03f, 3.162277630e-03f, 2.942727180e-03f, 2.738419687e-03f, 2.548296936e-03f, 2.371373586e-03f, 2.206734149e-03f, 2.053524833e-03f, 1.910952968e-03f, 1.778279431e-03f, 1.654817141e-03f, 1.539926510e-03f, 1.433012541e-03f, 1.333521446e-03f, 1.240937738e-03f, 1.154781901e-03f, 1.074607833e-03f, 1.000000047e-03f, 9.305720450e-04f, 8.659643354e-04f, 8.058421663e-04f, 7.498942432e-04f, 6.978305755e-04f, 6.493816618e-04f, 6.042963942e-04f, 5.623413017e-04f, 5.232990952e-04f, 4.869675322e-04f, 4.531583691e-04f, 4.216965172e-04f, 3.924189659e-04f, 3.651741426e-04f, 3.398208355e-04f, 3.162277571e-04f, 2.942727006e-04f, 2.738419571e-04f, 2.548296761e-04f, 2.371373703e-04f, 2.206734061e-04f, 2.053525095e-04f, 1.910952997e-04f, 1.778279402e-04f, 1.654817170e-04f, 1.539926452e-04f, 1.433012512e-04f, 1.333521504e-04f, 1.240937709e-04f, 1.154782003e-04f, 1.074607862e-04f};

constexpr size_t MiB = 1u << 20;
constexpr size_t WS_CTL = 0, CTL_ZERO_BYTES = 1 * MiB;
constexpr size_t WS_TAB = 1 * MiB;
constexpr size_t WS_WAO = 4 * MiB, WS_WRO = 12 * MiB, WS_WO = 44 * MiB, WS_WGU = 76 * MiB, WS_WD = 248 * MiB, WS_WPG = 334 * MiB, WS_WPU = 366 * MiB;
constexpr size_t WS_PB = 368 * MiB, WS_WIN = 376 * MiB, WS_XB = 608 * MiB;
constexpr size_t WS_QA = 736 * MiB, WS_KA = 832 * MiB, WS_VTG = 928 * MiB, WS_QR = 1024 * MiB, WS_KR = 1088 * MiB, WS_KPT = 1152 * MiB, WS_VTR = 1216 * MiB,
                 WS_GR = 1344 * MiB, WS_GA = 1472 * MiB, WS_GRT = 1600 * MiB;
constexpr size_t WS_ST = 376 * MiB, WS_OG = 632 * MiB, WS_LSE = 728 * MiB;
constexpr size_t WS_OATT = 736 * MiB, WS_RG = 768 * MiB;
constexpr size_t WS_MIX = 896 * MiB, WS_T = 1024 * MiB;
constexpr size_t WS_STAT = 1152 * MiB, WS_H1B = 1408 * MiB;
constexpr size_t WS_HID = 376 * MiB;
constexpr size_t WS_X8 = 1728 * MiB;
constexpr size_t WS_P1B = 736 * MiB;
constexpr size_t WS_P2B = 896 * MiB;
constexpr size_t WS_WG8 = 1792 * MiB;
constexpr size_t WS_END = 1824 * MiB;
static_assert(WS_OG + 96 * MiB <= WS_LSE && WS_LSE + 2 * MiB <= WS_QA && WS_RG + 128 * MiB <= WS_MIX && WS_T + 128 * MiB <= WS_STAT && WS_H1B + 128 * MiB <= WS_END && WS_HID + 344 * MiB <= WS_OATT && WS_GRT + 128 * MiB <= WS_X8 && WS_X8 + 64 * MiB <= WS_WG8 && WS_WG8 + 32 * MiB <= WS_END && WS_HID + 344 * MiB <= WS_P1B && WS_P1B + 128 * MiB <= WS_P2B && WS_P2B + 128 * MiB <= WS_T, "d_ws map");
constexpr int CW_TMO = 0, CW_WORK = 64;
constexpr int CW_BAR = 4096;

constexpr int RING_BYTES = 131072;
constexpr int LDSCTL_OFF = RING_BYTES, MISC_OFF = LDSCTL_OFF + 320;
constexpr int LDS_BYTES = 147456;
constexpr int NWAVES = 8;

__device__ __forceinline__ unsigned cvtpk(float lo, float hi) { f32x2_t v = {lo, hi}; bf16x2_t b = __builtin_convertvector(v, bf16x2_t); return __builtin_bit_cast(unsigned, b); }
__device__ __forceinline__ unsigned pk_fp8x4(float a, float b, float c, float d) { int w = __builtin_amdgcn_cvt_pk_fp8_f32(a, b, 0, false); w = __builtin_amdgcn_cvt_pk_fp8_f32(c, d, w, true); return (unsigned)w; }
__device__ __forceinline__ float bflo(unsigned w) { return __uint_as_float(w << 16); }
__device__ __forceinline__ float bfhi(unsigned w) { return __uint_as_float(w & 0xffff0000u); }
__device__ __forceinline__ float fexp2(float x) { return __builtin_amdgcn_exp2f(x); }
__device__ __forceinline__ float frcp(float x) { return __builtin_amdgcn_rcpf(x); }
__device__ __forceinline__ float sigmoidf_(float x) { return frcp(1.0f + fexp2(-1.4426950408889634f * x)); }
__device__ __forceinline__ float siluf_(float x) { return x * sigmoidf_(x); }
__device__ __forceinline__ void sincos_pos(float a, float& s, float& c) {
    const float k = rintf(a * 0.15915494309189535f);
    float r = fmaf(-k, 6.28125f, a);
    r = fmaf(-k, 1.935307179586232e-3f, r);
    const float rv = r * 0.15915494309189535f;
    s = __builtin_amdgcn_sinf(rv); c = __builtin_amdgcn_cosf(rv);
}
__device__ __forceinline__ int lane_now() { int l; asm volatile("v_mbcnt_lo_u32_b32 %0, -1, 0\n\tv_mbcnt_hi_u32_b32 %0, -1, %0" : "=v"(l)); return l; }
__device__ __forceinline__ float wave_sum(float v) {
#pragma unroll
    for (int o = 1; o < 64; o <<= 1) v += __shfl_xor(v, o);
    return v;
}

#define XB_TMO      128
#define XB_XCNT(j)  (256  + 64 * (j))
#define XB_XSUB(j)  (1280 + 64 * (j))
#define XB_XGEN(j)  (2304 + 64 * (j))
#define XB_TOP      3328
#define XB_TOPGEN   3392
#define XCD_BAR_WORDS 3456
#define XB_SPIN_CAP (1u << 18)
__device__ __forceinline__ unsigned xb_ld(unsigned* p)              { return __hip_atomic_load(p, __ATOMIC_RELAXED, __HIP_MEMORY_SCOPE_AGENT); }
__device__ __forceinline__ unsigned xb_add(unsigned* p, unsigned v) { return __hip_atomic_fetch_add(p, v, __ATOMIC_RELAXED, __HIP_MEMORY_SCOPE_AGENT); }
__device__ __forceinline__ unsigned xb_xcc_id() { return (unsigned)__builtin_amdgcn_s_getreg((3 << 11) | 20) & 0xFu; }
#define XB_SPIN(cond, bar) do { unsigned _sp = 0; while (cond) { __builtin_amdgcn_s_sleep(1); \
    if ((++_sp & 255u) == 0u) { if (xb_ld(&(bar)[XB_TMO])) break; if (_sp > XB_SPIN_CAP) { atomicAdd(&(bar)[XB_TMO], 1u); break; } } } } while (0)
struct XcdBarrier { unsigned* bar; unsigned x; volatile LAS unsigned* st; int wave; };
__device__ __forceinline__ XcdBarrier xcd_barrier_post(unsigned* bar, volatile LAS unsigned* st, int wave) {
    XcdBarrier b; b.bar = bar; b.x = xb_xcc_id(); b.st = st; b.wave = wave;
    if (wave == 0 && lane_now() == 0) (void)xb_add(&bar[XB_XCNT(b.x)], 1u);
    return b;
}
__device__ __forceinline__ void xcd_barrier_complete(unsigned* bar, unsigned x, unsigned& nloc, unsigned& nx) {
    const unsigned G = gridDim.x * gridDim.y * gridDim.z;
    unsigned sum, cnt, mine, sp = 0u;
    for (;;) {
        sum = 0u; cnt = 0u; mine = 0u;
#pragma unroll
        for (unsigned j = 0; j < 16; ++j) { const unsigned c = xb_ld(&bar[XB_XCNT(j)]); sum += c; cnt += (c > 0u) ? 1u : 0u; mine = (j == x) ? c : mine; }
        if (sum == G) break;
        __builtin_amdgcn_s_sleep(1);
        if ((++sp & 255u) == 0u) { if (xb_ld(&bar[XB_TMO])) break; if (sp > XB_SPIN_CAP) { atomicAdd(&bar[XB_TMO], 1u); break; } }
    }
    nloc = mine > 0u ? mine : 1u; nx = cnt > 0u ? cnt : 1u;
}
__device__ __forceinline__ void xcd_barrier(const XcdBarrier& b) {
    asm volatile("s_waitcnt vmcnt(0)" ::: "memory");
    __syncthreads();
    if (b.wave == 0 && lane_now() == 0) {
        unsigned* bar = b.bar;
        __builtin_amdgcn_s_waitcnt(0);
        unsigned nloc = b.st[0], nx = b.st[1];
        if (nloc == 0u) { xcd_barrier_complete(bar, b.x, nloc, nx); b.st[0] = nloc; b.st[1] = nx; }
        const unsigned old = xb_add(&bar[XB_XSUB(b.x)], 1u);
        const unsigned gen = old / nloc;
        if (old + 1u == (gen + 1u) * nloc) {
            __builtin_amdgcn_fence(__ATOMIC_RELEASE, "agent");
            asm volatile("s_waitcnt vmcnt(0)" ::: "memory");
            const unsigned og = xb_add(&bar[XB_TOP], 1u);
            const unsigned tg = og / nx;
            if (og + 1u == (tg + 1u) * nx) xb_add(&bar[XB_TOPGEN], 1u);
            else XB_SPIN(xb_ld(&bar[XB_TOPGEN]) == tg, bar);
            __builtin_amdgcn_fence(__ATOMIC_ACQUIRE, "agent");
            xb_add(&bar[XB_XGEN(b.x)], 1u);
            asm volatile("s_waitcnt vmcnt(0)" ::: "memory");
        } else {
            XB_SPIN(xb_ld(&bar[XB_XGEN(b.x)]) == gen, bar);
            __builtin_amdgcn_fence(__ATOMIC_ACQUIRE, "agent");
            asm volatile("s_waitcnt vmcnt(0)" ::: "memory");
        }
    }
    __syncthreads();
}

namespace ge {
constexpr int BM = 256, BK = 64, HALF = 128, HTB = HALF * BK * 2, STAGE_BYTES = 8 * HTB;
__host__ __device__ __forceinline__ int lds_byte(int r, int c) { const int st = (r >> 4) * 2 + (c >> 5), rr = r & 15, cc = c & 31, ob = rr * 64 + cc * 2; return st * 1024 + (ob ^ (((ob >> 9) & 1) << 5)); }
__host__ __device__ __forceinline__ void stage_rc(int b, int& R, int& C) { const int st = b / 1024, sb = b % 1024, swz = sb ^ (((sb >> 9) & 1) << 5); R = (st >> 1) * 16 + swz / 64; C = (st & 1) * 32 + (swz % 64) / 2; }
__host__ __device__ __forceinline__ int perm32(int rho) { const int n = rho >> 4, i = rho & 15; return 8 * (i >> 2) + 4 * n + (i & 3); }

enum Kind { K_SCALE = 0, K_ROT = 1, K_ROTT = 2, K_SILU = 3, K_SIG = 4, K_MID = 5, K_FIN = 6, K_WO = 7, K_SWIGLU = 8, K_PLE = 9, K_DOWN = 10 };
struct GU {
    const char* A; const char* B;
    char* out;
    const char* x0; const char* x1;
    unsigned sA, sB;
    int nt;
    unsigned ldo, ldx;
    int i0, i1;
    int pad[3];
};
static_assert(sizeof(GU) == 80, "unit table entry");
constexpr int GU_DW = 20;
__device__ __forceinline__ void tile_of(int local, int nM, int nN, int& pm, int& pn) {
    const int nwg = nM * nN; int wgid = local;
    { const int q = nwg / 8, r = nwg % 8, xcd = wgid % 8, off = wgid / 8; wgid = (xcd < r ? xcd * (q + 1) : r * (q + 1) + (xcd - r) * q) + off; }
    const int nig = 8 * nN, gid = wgid / nig, fm = gid * 8, gsz = (nM - fm) < 8 ? (nM - fm) : 8;
    pm = fm + ((wgid % nig) % gsz); pn = (wgid % nig) / gsz;
}

typedef f32x4 Acc[2][2][4][2];
#define EPI_FENCE() do { asm volatile("" ::: "memory"); __builtin_amdgcn_sched_barrier(0); } while (0)
__device__ __forceinline__ u32x4 pack8(const f32x4 a, const f32x4 b) { u32x4 w; w.x = cvtpk(a[0], a[1]); w.y = cvtpk(a[2], a[3]); w.z = cvtpk(b[0], b[1]); w.w = cvtpk(b[2], b[3]); return w; }
__device__ __forceinline__ void unpack8(const u32x4 w, f32x4& a, f32x4& b) { a = (f32x4){bflo(w.x), bfhi(w.x), bflo(w.y), bfhi(w.y)}; b = (f32x4){bflo(w.z), bfhi(w.z), bflo(w.w), bfhi(w.w)}; }

template <int MODE>
__device__ __forceinline__ void epi_bf16(Acc& acc, const GU& u, int r0, int c0) {
    const float f = __int_as_float(u.i0);
#pragma unroll
    for (int ai = 0; ai < 2; ++ai)
#pragma unroll
        for (int m = 0; m < 4; ++m) { EPI_FENCE(); char* rowp = u.out + (size_t)(r0 + ai * 128 + m * 16) * u.ldo + (size_t)c0 * 2;
#pragma unroll
            for (int bj = 0; bj < 2; ++bj) { const f32x4 a0 = acc[ai][bj][m][0], a1 = acc[ai][bj][m][1]; f32x4 v0, v1;
                if (MODE == 0) { v0 = a0 * f; v1 = a1 * f; }
                else if (MODE == 1) { v0 = (f32x4){siluf_(a0[0] * f), siluf_(a0[1] * f), siluf_(a0[2] * f), siluf_(a0[3] * f)}; v1 = (f32x4){siluf_(a1[0] * f), siluf_(a1[1] * f), siluf_(a1[2] * f), siluf_(a1[3] * f)}; }
                else { v0 = (f32x4){sigmoidf_(a0[0] * f), sigmoidf_(a0[1] * f), sigmoidf_(a0[2] * f), sigmoidf_(a0[3] * f)}; v1 = (f32x4){sigmoidf_(a1[0] * f), sigmoidf_(a1[1] * f), sigmoidf_(a1[2] * f), sigmoidf_(a1[3] * f)}; }
                *(GAS u32x4*)(rowp + bj * 256) = pack8(v0, v1); } }
}
__device__ __forceinline__ void mid_scale(Acc& acc, const GU& u, int wr, int wc) {
    const int ln = lane_now(), r0 = wr * 64 + (ln & 15), c0 = wc * 32 + 8 * (ln >> 4);
#pragma unroll
    for (int ai = 0; ai < 2; ++ai)
#pragma unroll
        for (int mp = 0; mp < 2; ++mp) { EPI_FENCE(); u32x4 wa[2][2], wg[2][2];
#pragma unroll
            for (int mm = 0; mm < 2; ++mm) { const size_t ro = (size_t)(r0 + ai * 128 + (2 * mp + mm) * 16) * u.ldx + (size_t)c0 * 2;
#pragma unroll
                for (int bj = 0; bj < 2; ++bj) { wa[mm][bj] = *(const GAS u32x4*)(u.x0 + ro + bj * 256); wg[mm][bj] = *(const GAS u32x4*)(u.x1 + ro + bj * 256); } }
#pragma unroll
            for (int mm = 0; mm < 2; ++mm)
#pragma unroll
                for (int bj = 0; bj < 2; ++bj) { const int m = 2 * mp + mm; f32x4 a0, a1, g0, g1; unpack8(wa[mm][bj], a0, a1); unpack8(wg[mm][bj], g0, g1);
#pragma unroll
                    for (int t = 0; t < 4; ++t) { acc[ai][bj][m][0][t] *= a0[t] * frcp(g0[t]); acc[ai][bj][m][1][t] *= a1[t] * frcp(g1[t]); } } }
}
#define KM(k) (KIND == (k))
template <int KIND>
__device__ __forceinline__ void epilogue(Acc& acc, const GU& u, int wr, int wc) {
    const int ln = lane_now(), r0 = wr * 64 + (ln & 15), c0 = wc * 32 + 8 * (ln >> 4);
    switch (KIND) {
    case K_SCALE: if constexpr (KM(K_SCALE)) { epi_bf16<0>(acc, u, r0, c0); } break;
    case K_SILU: if constexpr (KM(K_SILU)) { epi_bf16<1>(acc, u, r0, c0); } break;
    case K_SIG: if constexpr (KM(K_SIG)) { epi_bf16<2>(acc, u, r0, c0); } break;
    case K_ROT: if constexpr (KM(K_ROT)) {
        const float f = __int_as_float(u.i1);
        float invf[8];
#pragma unroll
        for (int j = 0; j < 8; ++j) invf[j] = INVF[c0 + j];
#pragma unroll
        for (int ai = 0; ai < 2; ++ai)
#pragma unroll
            for (int m = 0; m < 4; ++m) { EPI_FENCE(); const int row = r0 + ai * 128 + m * 16; const float pos = (float)((u.i0 + row) & (SEQ - 1));
                char* rowp = u.out + (size_t)row * u.ldo + (size_t)c0 * 2; f32x4 o1[2], o2[2];
#pragma unroll
                for (int n = 0; n < 2; ++n)
#pragma unroll
                    for (int t = 0; t < 4; ++t) { float s, c; sincos_pos(pos * invf[4 * n + t], s, c); const float t1 = acc[ai][0][m][n][t], t2 = acc[ai][1][m][n][t];
                        o1[n][t] = (t1 * c - t2 * s) * f; o2[n][t] = (t1 * s + t2 * c) * f; }
                *(GAS u32x4*)(rowp) = pack8(o1[0], o1[1]); *(GAS u32x4*)(rowp + 256) = pack8(o2[0], o2[1]); }
    } break;
    case K_ROTT: if constexpr (KM(K_ROTT)) {
        const float lg = LOG2G[u.i1]; float dec[8];
#pragma unroll
        for (int j = 0; j < 8; ++j) dec[j] = 0.0625f * fexp2((float)(127 - (c0 + j)) * lg);
#pragma unroll
        for (int m = 0; m < 4; ++m) { const int row = r0 + m * 16; const float iv = INVF[row];
#pragma unroll
            for (int bj = 0; bj < 2; ++bj) { EPI_FENCE(); f32x4 o1[2], o2[2];
#pragma unroll
                for (int n = 0; n < 2; ++n)
#pragma unroll
                    for (int t = 0; t < 4; ++t) { const float pos = (float)((u.i0 + bj * 128 + c0 + 4 * n + t) & (SEQ - 1)); float s, c; sincos_pos(pos * iv, s, c);
                        const float t1 = acc[0][bj][m][n][t], t2 = acc[1][bj][m][n][t], d = dec[4 * n + t];
                        o1[n][t] = (t1 * c - t2 * s) * d; o2[n][t] = (t1 * s + t2 * c) * d; }
                char* p1 = u.out + (size_t)row * u.ldo + (size_t)(bj * 128 + c0) * 2;
                *(GAS u32x4*)(p1) = pack8(o1[0], o1[1]); *(GAS u32x4*)(p1 + (size_t)128 * u.ldo) = pack8(o2[0], o2[1]); } }
    } break;
    case K_FIN: if constexpr (KM(K_FIN)) {
#pragma unroll
        for (int ai = 0; ai < 2; ++ai) { EPI_FENCE(); u32x4 wg[4][2];
#pragma unroll
            for (int m = 0; m < 4; ++m) { const size_t ro = (size_t)(r0 + ai * 128 + m * 16) * u.ldx + (size_t)c0 * 2;
#pragma unroll
                for (int bj = 0; bj < 2; ++bj) wg[m][bj] = *(const GAS u32x4*)(u.x1 + ro + bj * 256); }
#pragma unroll
            for (int m = 0; m < 4; ++m) { char* rowp = u.out + (size_t)(r0 + ai * 128 + m * 16) * u.ldo + (size_t)c0 * 2;
#pragma unroll
                for (int bj = 0; bj < 2; ++bj) { f32x4 g0, g1; unpack8(wg[m][bj], g0, g1);
                    *(GAS u32x4*)(rowp + bj * 256) = pack8(acc[ai][bj][m][0] * g0, acc[ai][bj][m][1] * g1); } } }
    } break;
    case K_WO: if constexpr (KM(K_WO)) {
        const float f = __int_as_float(u.i0);
#pragma unroll
        for (int ai = 0; ai < 2; ++ai)
#pragma unroll
            for (int mp = 0; mp < 2; ++mp) { EPI_FENCE(); f32x4 xv[2][2][2];
#pragma unroll
                for (int mm = 0; mm < 2; ++mm) { const size_t xo = (size_t)(r0 + ai * 128 + (2 * mp + mm) * 16) * u.ldx + (size_t)c0 * 4;
#pragma unroll
                    for (int bj = 0; bj < 2; ++bj) { xv[mm][bj][0] = *(const GAS f32x4*)(u.x0 + xo + bj * 512); xv[mm][bj][1] = *(const GAS f32x4*)(u.x0 + xo + bj * 512 + 16); } }
#pragma unroll
                for (int mm = 0; mm < 2; ++mm) { const int m = 2 * mp + mm; char* rowp = u.out + (size_t)(r0 + ai * 128 + m * 16) * u.ldo + (size_t)c0 * 2;
#pragma unroll
                    for (int bj = 0; bj < 2; ++bj) *(GAS u32x4*)(rowp + bj * 256) = pack8(xv[mm][bj][0] * f + acc[ai][bj][m][0], xv[mm][bj][1] * f + acc[ai][bj][m][1]); } }
    } break;
    case K_SWIGLU: if constexpr (KM(K_SWIGLU)) {
#pragma unroll
        for (int ai = 0; ai < 2; ++ai)
#pragma unroll
            for (int m = 0; m < 4; ++m) { EPI_FENCE(); char* rowp = u.out + (size_t)(r0 + ai * 128 + m * 16) * u.ldo + (size_t)c0 * 2; f32x4 h0, h1;
#pragma unroll
                for (int t = 0; t < 4; ++t) { h0[t] = siluf_(acc[ai][0][m][0][t]) * acc[ai][1][m][0][t]; h1[t] = siluf_(acc[ai][0][m][1][t]) * acc[ai][1][m][1][t]; }
                *(GAS u32x4*)(rowp) = pack8(h0, h1); }
    } break;
    case K_PLE: if constexpr (KM(K_PLE)) {
#pragma unroll
        for (int ai = 0; ai < 2; ++ai) { EPI_FENCE(); u32x4 wt[4][2];
#pragma unroll
            for (int m = 0; m < 4; ++m) { const size_t to = (size_t)(r0 + ai * 128 + m * 16) * u.ldx + (size_t)c0 * 2;
#pragma unroll
                for (int bj = 0; bj < 2; ++bj) wt[m][bj] = *(const GAS u32x4*)(u.x0 + to + bj * 256); }
#pragma unroll
            for (int m = 0; m < 4; ++m) { char* rowp = u.out + (size_t)(r0 + ai * 128 + m * 16) * u.ldo + (size_t)c0 * 2;
#pragma unroll
                for (int bj = 0; bj < 2; ++bj) { f32x4 t0, t1; unpack8(wt[m][bj], t0, t1); const f32x4 a0 = acc[ai][bj][m][0], a1 = acc[ai][bj][m][1];
                    const f32x4 o0 = {sigmoidf_(a0[0]) * t0[0], sigmoidf_(a0[1]) * t0[1], sigmoidf_(a0[2]) * t0[2], sigmoidf_(a0[3]) * t0[3]};
                    const f32x4 o1 = {sigmoidf_(a1[0]) * t1[0], sigmoidf_(a1[1]) * t1[1], sigmoidf_(a1[2]) * t1[2], sigmoidf_(a1[3]) * t1[3]};
                    *(GAS u32x4*)(rowp + bj * 256) = pack8(o0, o1); } } }
    } break;
    case K_DOWN: if constexpr (KM(K_DOWN)) {
        const GAS f32x2_t* stat = (const GAS f32x2_t*)u.x0 + u.i0; const GAS f32x4* gb = (const GAS f32x4*)((const GAS f32x2_t*)u.x0 + M + u.i1 + c0);
        f32x4 gbv[2][4];
#pragma unroll
        for (int bj = 0; bj < 2; ++bj)
#pragma unroll
            for (int j = 0; j < 4; ++j) gbv[bj][j] = gb[bj * 64 + j];
#pragma unroll
        for (int ai = 0; ai < 2; ++ai)
#pragma unroll
            for (int mp = 0; mp < 2; ++mp) { EPI_FENCE(); u32x4 xw[2][2]; u32x4 pl[2][2]; f32x2_t st[2];
#pragma unroll
                for (int mm = 0; mm < 2; ++mm) { const int row = r0 + ai * 128 + (2 * mp + mm) * 16; const size_t po = (size_t)row * u.ldx + (size_t)c0 * 2; const char* xp = u.x1 + ((ptrdiff_t)WS_P1B - (ptrdiff_t)WS_T) + po; st[mm] = stat[row];
#pragma unroll
                    for (int bj = 0; bj < 2; ++bj) { xw[mm][bj] = *(const GAS u32x4*)(xp + bj * 256); pl[mm][bj] = *(const GAS u32x4*)(u.x1 + po + bj * 256); } }
#pragma unroll
                for (int mm = 0; mm < 2; ++mm) { const int m = 2 * mp + mm; char* rowp = (char*)u.x1 + ((ptrdiff_t)WS_P2B - (ptrdiff_t)WS_T) + (size_t)(r0 + ai * 128 + m * 16) * u.ldx + (size_t)c0 * 2; const float mu = st[mm][0], rs = st[mm][1];
#pragma unroll
                    for (int bj = 0; bj < 2; ++bj) { f32x4 p0, p1, x0, x1; unpack8(pl[mm][bj], p0, p1); unpack8(xw[mm][bj], x0, x1); const f32x4 a0 = acc[ai][bj][m][0], a1 = acc[ai][bj][m][1];
                        const f32x4 g01 = gbv[bj][0], g23 = gbv[bj][1], g45 = gbv[bj][2], g67 = gbv[bj][3];
                        const f32x4 o0 = {(x0[0] - mu) * rs * g01[0] + g01[1] + p0[0] + a0[0], (x0[1] - mu) * rs * g01[2] + g01[3] + p0[1] + a0[1], (x0[2] - mu) * rs * g23[0] + g23[1] + p0[2] + a0[2], (x0[3] - mu) * rs * g23[2] + g23[3] + p0[3] + a0[3]};
                        const f32x4 o1 = {(x1[0] - mu) * rs * g45[0] + g45[1] + p1[0] + a1[0], (x1[1] - mu) * rs * g45[2] + g45[3] + p1[1] + a1[1], (x1[2] - mu) * rs * g67[0] + g67[1] + p1[2] + a1[2], (x1[3] - mu) * rs * g67[2] + g67[3] + p1[3] + a1[3]};
                        *(GAS u32x4*)(rowp + bj * 256) = pack8(o0, o1); } } }
    } break;
    default: break;
    }
}

#define CAS __attribute__((address_space(4)))
__device__ __forceinline__ bool fetch_unit(const unsigned* tab, int i, int count, GU& u) {
    if (i >= count) return false;
    const CAS unsigned long long* e8 = (const CAS unsigned long long*)(const CAS void*)(tab + (size_t)i * GU_DW);
    const CAS unsigned* e4 = (const CAS unsigned*)e8;
    u.A = (const char*)e8[0]; u.B = (const char*)e8[1]; u.out = (char*)e8[2]; u.x0 = (const char*)e8[3]; u.x1 = (const char*)e8[4];
    u.sA = e4[10]; u.sB = e4[11]; u.nt = (int)e4[12]; u.ldo = e4[13]; u.ldx = e4[14]; u.i0 = (int)e4[15]; u.i1 = (int)e4[16];
    return u.nt != 0;
}
template <int KIND, int CHAIN, bool FP8 = false, bool ALT = false>
__device__ __forceinline__ void gemm_stream(LAS unsigned char* lds, const unsigned* tab, int count, int wid) {
    const int wr = wid >> 2, wc = wid & 3;
    int aoff, boff; { const int lane = lane_now(), fr = lane & 15, fq = lane >> 4; aoff = lds_byte(wr * 64 + fr, fq * 8); boff = lds_byte(wc * 32 + fr, fq * 8); }
#define GE_LANE_RC(rA0, rB0, cc0) unsigned rA0, rB0, cc0; { const int _t = wid * 64 + lane_now(); int R, C; stage_rc(_t * 16, R, C); rA0 = (unsigned)R; rB0 = (unsigned)((R & ~31) + perm32(R & 31)); cc0 = (unsigned)C * 2u; }
    const unsigned ldsw = (unsigned)wid * 1024u;
    const unsigned ldsbase = (unsigned)__builtin_amdgcn_readfirstlane((int)((unsigned)(size_t)lds + ldsw));
#define GE_SA(b, h) (((b) * 2 + (h)) * HTB)
#define GE_SB(b, h) ((4 + (b) * 2 + (h)) * HTB)
#define GE_DMA(sbase, voff, ldsaddr) do { unsigned _keep; asm volatile("s_mov_b32 %0, m0\n\ts_mov_b32 m0, %3\n\ts_nop 0\n\tglobal_load_lds_dwordx4 %1, %2\n\ts_mov_b32 m0, %0" \
        : "=&s"(_keep) : "v"(voff), "s"(sbase), "s"(ldsaddr) : "memory"); } while (0)
#define GE_STAGE(bufoff, gbase, voff, s64) do { const char* _b0 = (const char*)(gbase); const char* _b1 = _b0 + (s64); \
        GE_DMA(_b0, (voff), ldsbase + (unsigned)(bufoff)); GE_DMA(_b1, (voff), ldsbase + (unsigned)(bufoff) + 8192u); } while (0)
#define GE_LDA(dst, b, h) do { _Pragma("unroll") for (int m = 0; m < 4; ++m) _Pragma("unroll") for (int k = 0; k < 2; ++k) dst[m][k] = *(const LAS bf16x8*)(lds + GE_SA(b, h) + aoff + m * 2048 + k * 1024); } while (0)
#define GE_LDB(dst, b, h) do { _Pragma("unroll") for (int n = 0; n < 2; ++n) _Pragma("unroll") for (int k = 0; k < 2; ++k) dst[n][k] = *(const LAS bf16x8*)(lds + GE_SB(b, h) + boff + n * 2048 + k * 1024); } while (0)
#define GE_MMA(ai, bj, At, Bt) do { __builtin_amdgcn_s_setprio(1); \
        if (FP8) { typedef int i4_t __attribute__((ext_vector_type(4))); typedef int i8_t __attribute__((ext_vector_type(8))); \
            _Pragma("unroll") for (int m = 0; m < 4; ++m) _Pragma("unroll") for (int n = 0; n < 2; ++n) { \
                const i8_t a8 = __builtin_shufflevector(__builtin_bit_cast(i4_t, At[m][0]), __builtin_bit_cast(i4_t, At[m][1]), 0, 1, 2, 3, 4, 5, 6, 7); \
                const i8_t b8 = __builtin_shufflevector(__builtin_bit_cast(i4_t, Bt[n][0]), __builtin_bit_cast(i4_t, Bt[n][1]), 0, 1, 2, 3, 4, 5, 6, 7); \
                acc[ai][bj][m][n] = __builtin_amdgcn_mfma_scale_f32_16x16x128_f8f6f4(b8, a8, acc[ai][bj][m][n], 0, 0, 0, 0x7F7F7F7F, 0, 0x79797979); \
                asm volatile("" : "+v"(acc[ai][bj][m][n])); } } \
        else { _Pragma("unroll") for (int m = 0; m < 4; ++m) _Pragma("unroll") for (int n = 0; n < 2; ++n) _Pragma("unroll") for (int k = 0; k < 2; ++k) \
            acc[ai][bj][m][n] = __builtin_amdgcn_mfma_f32_16x16x32_bf16(Bt[n][k], At[m][k], acc[ai][bj][m][n], 0, 0, 0); } \
        __builtin_amdgcn_s_setprio(0); } while (0)
#define GE_WAIT_V(n) asm volatile("s_waitcnt vmcnt(" #n ")" ::: "memory")
#define GE_WAIT_L(n) asm volatile("s_waitcnt lgkmcnt(" #n ")" ::: "memory")
#define GE_BAR __builtin_amdgcn_s_barrier()
#define GE_SCHED __builtin_amdgcn_sched_barrier(0)
#define GE_ZERO() do { _Pragma("unroll") for (int a = 0; a < 2; ++a) _Pragma("unroll") for (int b = 0; b < 2; ++b) _Pragma("unroll") for (int m = 0; m < 4; ++m) _Pragma("unroll") for (int n = 0; n < 2; ++n) acc[a][b][m][n] = (f32x4){0.f, 0.f, 0.f, 0.f}; } while (0)
#define GE_BODY(a1, a2, b2, a3, b3, v2A, v2B, h2A, h2B, q2A, q2B) do { \
            GE_LDB(B0, 0, 0); GE_LDB(B1, 0, 1); GE_SCHED; GE_LDA(At, 0, 0); GE_STAGE(GE_SA(1, 1), (a1) + chA, cvA, cqA); \
            GE_WAIT_V(8); GE_WAIT_L(0); GE_BAR; GE_MMA(0, 0, At, B0); GE_MMA(0, 1, At, B1); GE_BAR; GE_SCHED; \
            GE_LDA(At, 0, 1); GE_STAGE(GE_SB(0, 0), (b2), v2B, q2B); GE_STAGE(GE_SB(0, 1), (b2) + (h2B), v2B, q2B); GE_STAGE(GE_SA(0, 0), (a2), v2A, q2A); \
            GE_WAIT_V(8); GE_WAIT_L(0); GE_BAR; GE_MMA(1, 0, At, B0); GE_MMA(1, 1, At, B1); GE_BAR; GE_SCHED; \
            GE_LDB(B0, 1, 0); GE_LDB(B1, 1, 1); GE_SCHED; GE_LDA(At, 1, 0); GE_STAGE(GE_SA(0, 1), (a2) + (h2A), v2A, q2A); \
            GE_WAIT_V(8); GE_WAIT_L(0); GE_BAR; GE_MMA(0, 0, At, B0); GE_MMA(0, 1, At, B1); GE_BAR; GE_SCHED; \
            GE_LDA(At, 1, 1); GE_STAGE(GE_SB(1, 0), (b3), v2B, q2B); GE_STAGE(GE_SB(1, 1), (b3) + (h2B), v2B, q2B); GE_STAGE(GE_SA(1, 0), (a3), v2A, q2A); \
            GE_WAIT_V(8); GE_WAIT_L(0); GE_BAR; GE_MMA(1, 0, At, B0); GE_MMA(1, 1, At, B1); GE_BAR; GE_SCHED; } while (0)
    GU cur, nxt; int ui = 0;
    if (!fetch_unit(tab, 0, count, cur)) return;
    Acc acc; GE_ZERO();
    bf16x8 At[4][2], B0[2][2], B1[2][2];
    unsigned cvA, cvB; { GE_LANE_RC(rA0, rB0, cc0); cvA = rA0 * cur.sA + cc0; cvB = rB0 * cur.sB + cc0; }
    const char* cA = cur.A; const char* cB = cur.B; size_t chA = (size_t)128 * cur.sA, chB = (size_t)128 * cur.sB, cqA = (size_t)64 * cur.sA, cqB = (size_t)64 * cur.sB;
    ptrdiff_t kstep = ALT ? -128 : 128;
    GE_STAGE(GE_SB(0, 0), cB, cvB, cqB); GE_STAGE(GE_SB(0, 1), cB + chB, cvB, cqB); GE_STAGE(GE_SA(0, 0), cA, cvA, cqA); GE_STAGE(GE_SA(0, 1), cA + chA, cvA, cqA);
    if (wr == 1) GE_BAR;
    GE_WAIT_V(2); GE_BAR;
    GE_STAGE(GE_SB(1, 0), cB + kstep, cvB, cqB); GE_STAGE(GE_SA(1, 0), cA + kstep, cvA, cqA); GE_STAGE(GE_SB(1, 1), cB + chB + kstep, cvB, cqB);
    GE_WAIT_V(6); GE_BAR;
    for (;;) {
        const bool has_next = fetch_unit(tab, ui + 1, count, nxt);
        const int nt = cur.nt;
        for (int t = 0; t < nt - 2; t += 2) {
            const char* a1 = cA + (ptrdiff_t)(t + 1) * kstep; const char* a2 = cA + (ptrdiff_t)(t + 2) * kstep; const char* b2 = cB + (ptrdiff_t)(t + 2) * kstep;
            GE_BODY(a1, a2, b2, a2 + kstep, b2 + kstep, cvA, cvB, chA, chB, cqA, cqB);
        }
        {
            const char* nA = cA; const char* nB = cB; size_t nhA = chA, nhB = chB, nqA = cqA, nqB = cqB; unsigned nvA = cvA, nvB = cvB;
            if (has_next) { nA = nxt.A; nB = nxt.B; nhA = (size_t)128 * nxt.sA; nhB = (size_t)128 * nxt.sB; nqA = (size_t)64 * nxt.sA; nqB = (size_t)64 * nxt.sB; GE_LANE_RC(rA0, rB0, cc0); nvA = rA0 * nxt.sA + cc0; nvB = rB0 * nxt.sB + cc0; }
            const char* a1 = cA + (ptrdiff_t)(nt - 1) * kstep; const ptrdiff_t nks = ALT ? (has_next ? -kstep : kstep) : 128;
            GE_BODY(a1, nA, nB, nA + nks, nB + nks, nvA, nvB, nhA, nhB, nqA, nqB);
            if (wr == 0) GE_BAR;
            if (CHAIN == 1 && !(ui & 1)) { mid_scale(acc, cur, wr, wc); }
            else if (CHAIN == 2) { epilogue<KIND>(acc, cur, wr, wc); const float f = __int_as_float(cur.i1);
                _Pragma("unroll") for (int a = 0; a < 2; ++a) _Pragma("unroll") for (int b = 0; b < 2; ++b) _Pragma("unroll") for (int m = 0; m < 4; ++m) _Pragma("unroll") for (int n = 0; n < 2; ++n) { acc[a][b][m][n] = acc[a][b][m][n] * f; asm volatile("" : "+v"(acc[a][b][m][n])); } }
            else { epilogue<KIND>(acc, cur, wr, wc); if (has_next) GE_ZERO(); }
            if (!has_next) break;
            cur = nxt; cA = nA; cB = nB; chA = nhA; chB = nhB; cqA = nqA; cqB = nqB; cvA = nvA; cvB = nvB; if (ALT) kstep = -kstep;
            ++ui;
            if (wr == 1) GE_BAR;
        }
    }
    GE_WAIT_V(0);
    GE_BAR;
#undef GE_BODY
#undef GE_LANE_RC
#undef GE_SA
#undef GE_SB
#undef GE_STAGE
#undef GE_LDA
#undef GE_LDB
#undef GE_MMA
#undef GE_WAIT_V
#undef GE_WAIT_L
#undef GE_BAR
#undef GE_SCHED
#undef GE_ZERO
}
}

struct Args { const float* in[16]; float* out; unsigned char* ws; int ph_lo, ph_hi; };
struct Frame {
    LAS unsigned char* lds;
    gu32* ctl;
    int wave, G, c;
    unsigned char* ws;
};

__device__ __forceinline__ int perm_tile_token0(int g, int tile) {
    const int sh = 2 * g, L = SEQ >> sh, m0 = tile * 256, b = m0 >> 12, rem = m0 & (SEQ - 1), r = rem / L, j0 = rem % L;
    return (b << 12) + (j0 << sh) + r;
}

constexpr int SL_P1 = 0, SL_P1B = 13, SL_P1C = 17, SL_P1D = 19, SL_P1E = 23, SL_P3 = 31, SL_P3B = 35, SL_P4 = 43, SL_P5 = 47, SL_P5B = 69, SL_P6 = 74, SL_SCAN = 78, SL_G2 = 109, GX = 3, NSLOT = 109 + 2 * GX;
__device__ __forceinline__ void make_unit(int slot, int c, unsigned char* ws, const float* x, float* outp, ge::GU& u) {
    const char* xb = (const char*)(ws + WS_XB); const char* win = (const char*)(ws + WS_WIN);
    const unsigned rowK = D * 2;
    u.A = nullptr; u.B = nullptr; u.out = nullptr; u.x0 = nullptr; u.x1 = nullptr; u.sA = rowK; u.sB = rowK; u.nt = D / 64; u.ldo = 0; u.ldx = 0; u.i0 = __float_as_int(1.0f); u.i1 = 0; u.pad[0] = u.pad[1] = u.pad[2] = 0;
    if (slot >= SL_G2) {
        const int idx = c >> 3;
        if (c < 64 || (idx % 3) == 2) { u.nt = 0; return; }
        const int k = (idx - 8) - ((idx - 8) / 3 + 1), j = slot - SL_G2;
        c = ((2 * k + j / GX) << 3) | (c & 7); slot = SL_P1E + (8 - GX) + j % GX;
    }
    int pm, pn;
    const char* x8 = (const char*)(ws + WS_X8); const unsigned row8 = D;
    if (slot < 6) {
        const int isK = slot >= 3, g = isK ? slot - 3 : slot; ge::tile_of(c, 64, 4, pm, pn);
        u.A = x8 + (size_t)perm_tile_token0(g, pm) * row8; u.sA = row8 << (2 * g);
        u.B = win + (size_t)((isK ? 3072 : 0) + g * 1024 + pn * 256) * rowK; u.nt = D / 128;
        u.i0 = __float_as_int(isK ? 1.0f : QSCALE);
        u.out = (char*)ws + (isK ? WS_KA : WS_QA) + (size_t)g * ((size_t)M * 1024 * 2) + ((size_t)pm * 256 * 1024 + pn * 256) * 2; u.ldo = 1024 * 2;
    } else if (slot < 9) {
        const int g = slot - 6; ge::tile_of(c, 4, 64, pm, pn);
        u.A = win + (size_t)(6144 + g * 1024 + pm * 256) * rowK;
        u.B = x8 + (size_t)perm_tile_token0(g, pn) * row8; u.sB = row8 << (2 * g); u.nt = D / 128;
        u.out = (char*)ws + WS_VTG + (size_t)g * ((size_t)1024 * M * 2) + ((size_t)pm * 256 * M + pn * 256) * 2; u.ldo = M * 2;
    } else if (slot < 13) {
        ge::tile_of((slot - 9) * 256 + c, 16, 64, pm, pn);
        u.A = win + (size_t)(13312 + pm * 256) * rowK; u.B = xb + (size_t)pn * 256 * rowK;
        u.out = (char*)ws + WS_VTR + ((size_t)pm * 256 * M + pn * 256) * 2; u.ldo = M * 2;
    } else if (slot < 17) {
        const int isK = slot >= 15; ge::tile_of((slot - (isK ? 15 : 13)) * 256 + c, 64, 8, pm, pn);
        u.A = xb + (size_t)pm * 256 * rowK; u.B = win + (size_t)((isK ? 11264 : 9216) + pn * 256) * rowK;
        u.i0 = (pm * 256) & (SEQ - 1); u.i1 = __float_as_int(isK ? 0.0625f : 1.0f);
        u.out = (char*)ws + (isK ? WS_KR : WS_QR) + ((size_t)pm * 256 * 2048 + pn * 256) * 2; u.ldo = 2048 * 2;
    } else if (slot < 19) {
        ge::tile_of((slot - 17) * 256 + c, 8, 64, pm, pn);
        u.A = win + (size_t)(11264 + pm * 256) * rowK; u.B = xb + (size_t)pn * 256 * rowK;
        u.i0 = (pn * 256) & (SEQ - 1); u.i1 = pm;
        u.out = (char*)ws + WS_KPT + ((size_t)pm * 256 * M + pn * 256) * 2; u.ldo = M * 2;
    } else if (slot < 31) {
        const int sgm = (slot - 19) >> 2; ge::tile_of(((slot - 19) & 3) * 256 + c, 64, 16, pm, pn);
        u.A = xb + (size_t)pm * 256 * rowK; u.B = win + (size_t)(17408 + sgm * 4096 + pn * 256) * rowK;
        if (sgm != 0) { u.A = x8 + (size_t)pm * 256 * row8; u.sA = row8; u.nt = D / 128; u.B = (const char*)ws + WS_WG8 + (size_t)((sgm - 1) * 4096 + pn * 256) * row8; u.sB = row8; }
        u.out = (char*)ws + (sgm == 0 ? WS_GR : (sgm == 1 ? WS_GA : WS_GRT)) + ((size_t)pm * 256 * D + pn * 256) * 2; u.ldo = D * 2;
    } else if (slot < 35) {
        ge::tile_of((slot - 31) * 256 + c, 64, 16, pm, pn);
        u.A = (const char*)ws + WS_PB + (size_t)pm * 256 * PLE * 2; u.sA = PLE * 2; u.B = (const char*)ws + WS_WPU + (size_t)pn * 256 * PLE * 2; u.sB = PLE * 2; u.nt = PLE / 64;
        u.out = (char*)ws + WS_T + ((size_t)pm * 256 * D + pn * 256) * 2; u.ldo = D * 2;
    } else if (slot < 43) {
        const int j = slot - 35, part = j & 1; ge::tile_of((j >> 1) * 256 + c, 64, 16, pm, pn);
        const size_t go = ((size_t)pm * 256 * D + pn * 256) * 2;
        u.x0 = (const char*)ws + WS_GA + go; u.x1 = (const char*)ws + WS_GRT + go; u.ldx = D * 2; u.out = (char*)ws + WS_MIX + go; u.ldo = D * 2;
        if (part == 0) { u.A = (const char*)ws + WS_OATT + (size_t)pm * 256 * 1024 * 2; u.sA = 1024 * 2; u.B = (const char*)ws + WS_WAO + (size_t)pn * 256 * 1024 * 2; u.sB = 1024 * 2; u.nt = 1024 / 64; }
        else           { u.A = (const char*)ws + WS_RG + (size_t)pm * 256 * D * 2; u.B = (const char*)ws + WS_WRO + (size_t)pn * 256 * D * 2; }
    } else if (slot < 47) {
        ge::tile_of((slot - 43) * 256 + c, 64, 16, pm, pn);
        u.A = (const char*)ws + WS_MIX + (size_t)pm * 256 * D * 2; u.B = (const char*)ws + WS_WO + (size_t)pn * 256 * D * 2;
        u.i0 = __float_as_int(ALPHA); const size_t fo = ((size_t)pm * 256 * D + pn * 256) * 4;
        u.x0 = (const char*)x + fo; u.ldx = D * 4; u.out = (char*)ws + WS_P1B + fo / 2; u.ldo = D * 2;
    } else if (slot < 69) {
        const int L = (slot - 47) * 256 + c;
        if (L >= 64 * 86) { u.nt = 0; return; }
        ge::tile_of(L, 64, 86, pm, pn);
        u.A = (const char*)ws + WS_H1B + (size_t)pm * 256 * D * 2; u.B = (const char*)ws + WS_WGU + (size_t)pn * 256 * D * 2;
        u.out = (char*)ws + WS_HID + ((size_t)pm * 256 * FF + pn * 128) * 2; u.ldo = FF * 2;
    } else if (slot < 74) {
        const int j = slot - 69;
        if (j >= 3 && c < 128) { u.nt = 0; return; }
        ge::tile_of(j < 3 ? j * 256 + c : 768 + (j - 3) * 128 + (c - 128), 64, 16, pm, pn);
        u.A = x8 + (size_t)pm * 256 * row8; u.sA = row8; u.nt = D / 128; u.B = (const char*)ws + WS_WPG + (size_t)pn * 256 * D * 2;
        u.x0 = (const char*)ws + WS_T + ((size_t)pm * 256 * D + pn * 256) * 2; u.ldx = D * 2;
        u.out = (char*)ws + WS_T + ((size_t)pm * 256 * D + pn * 256) * 2; u.ldo = D * 2;
    } else if (slot < 78) {
        ge::tile_of((slot - 74) * 256 + c, 64, 16, pm, pn);
        u.A = (const char*)ws + WS_HID + (size_t)pm * 256 * FF * 2; u.sA = FF * 2; u.B = (const char*)ws + WS_WD + (size_t)pn * 256 * FF * 2; u.sB = FF * 2; u.nt = FF / 64;
        if (!((slot - 74) & 1)) { u.A += (size_t)(FF / 64 - 1) * 128; u.B += (size_t)(FF / 64 - 1) * 128; }
        u.i0 = pm * 256; u.i1 = pn * 256; const size_t fo = ((size_t)pm * 256 * D + pn * 256) * 4;
        u.x0 = (const char*)ws + WS_STAT; u.x1 = (const char*)ws + WS_T + fo / 2; u.ldx = D * 2;
    } else {
        if (c >= 64) { u.nt = 0; return; }
        const int n = slot - 78, b = c >> 4, h = (c >> 1) & 7, eh = c & 1;
        u.A = (const char*)ws + WS_VTR + ((size_t)(h * 512 + eh * 256) * M + b * SEQ + n * 128) * 2; u.sA = M * 2;
        u.B = (const char*)ws + WS_KPT + ((size_t)(h * 256) * M + b * SEQ + n * 128) * 2; u.sB = M * 2; u.nt = 2;
        u.out = (char*)ws + WS_ST + ((size_t)((b * 8 + h) * 32 + n + 1) * 512 + eh * 256) * 256 * 2; u.ldo = 256 * 2;
        u.i0 = __float_as_int(1.0f); u.i1 = __float_as_int(exp2f(128.0f * LOG2G[h]));
    }
}

__device__ __forceinline__ void p0_transpose_item(const float* W, int K, int N, bf16* WT, int mode, LAS float* scr, int item, int lane) {
    const int nblk = N / 32, kb = item / nblk, nb = item % nblk, k0 = 64 * kb, n0 = 32 * nb;
    { f32x4 v[8]; const int c4 = 4 * (lane & 7);
#pragma unroll
      for (int i = 0; i < 8; ++i) v[i] = *(const GAS f32x4*)(W + (size_t)(k0 + 8 * i + (lane >> 3)) * N + n0 + c4);
#pragma unroll
      for (int i = 0; i < 8; ++i) { LAS float* d = scr + (8 * i + (lane >> 3)) * 33 + c4; d[0] = v[i][0]; d[1] = v[i][1]; d[2] = v[i][2]; d[3] = v[i][3]; } }
    LDS_WAIT(); asm volatile("" ::: "memory");
    const int c = lane & 7;
    const int nbase = (mode == 0 || mode >= 3) ? n0 : ((n0 >> 7) * 256 + (n0 & 127) + (mode == 2 ? 128 : 0));
#pragma unroll
    for (int j = 0; j < 4; ++j) { const int n = (lane >> 3) + 8 * j; const LAS float* s = scr + (8 * c) * 33 + n;
        if (mode >= 3) { u32x2 o8; o8.x = pk_fp8x4(64.f * s[0 * 33], 64.f * s[1 * 33], 64.f * s[2 * 33], 64.f * s[3 * 33]); o8.y = pk_fp8x4(64.f * s[4 * 33], 64.f * s[5 * 33], 64.f * s[6 * 33], 64.f * s[7 * 33]);
            *(GAS u32x2*)((char*)WT + (size_t)(nbase + n) * (mode == 3 ? K * 2 : K) + k0 + 8 * c) = o8; continue; }
        u32x4 o; o.x = cvtpk(s[0 * 33], s[1 * 33]); o.y = cvtpk(s[2 * 33], s[3 * 33]); o.z = cvtpk(s[4 * 33], s[5 * 33]); o.w = cvtpk(s[6 * 33], s[7 * 33]);
        *(GAS u32x4*)(WT + (size_t)(nbase + n) * K + k0 + 8 * c) = o; }
    LDS_WAIT(); asm volatile("" ::: "memory");
}
constexpr int I_IN = (D / 64) * (NIN / 32), I_AO = (1024 / 64) * (D / 32), I_SQ = (D / 64) * (D / 32), I_FF = (D / 64) * (FF / 32), I_DN = (FF / 64) * (D / 32), I_PU = (PLE / 64) * (D / 32);
constexpr int N_LATE = I_AO + 3 * I_SQ + 2 * I_FF + I_DN + I_PU;
__device__ __forceinline__ void late_weight_item(const Args& a, unsigned char* ws, LAS float* scr, int r, int lane) {
    if (r < I_AO) { p0_transpose_item(a.in[3], 1024, D, (bf16*)(ws + WS_WAO), 0, scr, r, lane); return; } r -= I_AO;
    if (r < I_SQ) { p0_transpose_item(a.in[4], D, D, (bf16*)(ws + WS_WRO), 0, scr, r, lane); return; } r -= I_SQ;
    if (r < I_SQ) { p0_transpose_item(a.in[6], D, D, (bf16*)(ws + WS_WO), 0, scr, r, lane); return; } r -= I_SQ;
    if (r < I_FF) { p0_transpose_item(a.in[9], D, FF, (bf16*)(ws + WS_WGU), 1, scr, r, lane); return; } r -= I_FF;
    if (r < I_FF) { p0_transpose_item(a.in[10], D, FF, (bf16*)(ws + WS_WGU), 2, scr, r, lane); return; } r -= I_FF;
    if (r < I_DN) { p0_transpose_item(a.in[11], FF, D, (bf16*)(ws + WS_WD), 0, scr, r, lane); return; } r -= I_DN;
    if (r < I_SQ) { p0_transpose_item(a.in[12], D, D, (bf16*)(ws + WS_WPG), 3, scr, r, lane); return; } r -= I_SQ;
    p0_transpose_item(a.in[13], PLE, D, (bf16*)(ws + WS_WPU), 0, scr, r, lane);
}
__device__ __forceinline__ void late_weights_queue(Frame& F, const Args& a, int cw) {
    LAS float* scr = (LAS float*)(F.lds + F.wave * 16384);
    unsigned cur = 0u, end = 0u;
    for (;;) {
        const int lane = lane_now();
        if (cur == end) { unsigned idx = 0;
            if (lane == 0) idx = __hip_atomic_fetch_add((unsigned*)(F.ctl + cw), 64u, RLX_AGENT);
            idx = (unsigned)__builtin_amdgcn_readfirstlane((int)idx);
            if (idx >= (unsigned)N_LATE) break;
            cur = idx; end = idx + 64u < (unsigned)N_LATE ? idx + 64u : (unsigned)N_LATE; }
        late_weight_item(a, F.ws, scr, (int)cur, lane); ++cur;
    }
}
__device__ __forceinline__ void p0_prologue(Frame& F, const Args& a) {
    const int lane = lane_now(), tid = F.wave * 64 + lane;
    if (tid < NSLOT) { ge::GU u; make_unit(tid, F.c, F.ws, a.in[0], a.out, u);
        GAS unsigned* dst = (GAS unsigned*)(F.ws + WS_TAB) + ((size_t)F.c * NSLOT + tid) * ge::GU_DW; const unsigned* src = (const unsigned*)&u;
#pragma unroll
        for (int k = 0; k < ge::GU_DW; ++k) dst[k] = src[k]; }
    LAS float* scr = (LAS float*)(F.lds + F.wave * 16384);
    const int gw = F.c * NWAVES + F.wave, NGW = F.G * NWAVES;
    unsigned char* ws = F.ws;
    for (int it = gw; it < I_IN; it += NGW) { const int n0 = 32 * (it % (NIN / 32));
        if (n0 >= 21504) p0_transpose_item(a.in[2], D, NIN, (bf16*)(ws + WS_WG8 - (size_t)21504 * D), 4, scr, it, lane);
        else p0_transpose_item(a.in[2], D, NIN, (bf16*)(ws + WS_WIN), n0 < 9216 ? 3 : 0, scr, it, lane); }
    const size_t gt = (size_t)F.c * 512 + tid, NT = (size_t)F.G * 512;
    { const GAS f32x4* src = (const GAS f32x4*)a.in[0]; GAS u32x4* dst = (GAS u32x4*)(ws + WS_XB);
      GAS u32x2* dst8 = (GAS u32x2*)(ws + WS_X8);
      for (size_t i = gt; i < (size_t)M * D / 8; i += NT) { const f32x4 v0 = src[2 * i], v1 = src[2 * i + 1]; dst[i] = ge::pack8(v0, v1);
          u32x2 w8; w8.x = pk_fp8x4(v0[0], v0[1], v0[2], v0[3]); w8.y = pk_fp8x4(v1[0], v1[1], v1[2], v1[3]); dst8[i] = w8; } }
    { const GAS f32x4* src = (const GAS f32x4*)a.in[1]; GAS u32x4* dst = (GAS u32x4*)(ws + WS_PB);
      for (size_t i = gt; i < (size_t)M * PLE / 8; i += NT) { const f32x4 v0 = src[2 * i], v1 = src[2 * i + 1]; dst[i] = ge::pack8(v0, v1); } }
}

#define MFMA32(a, b, c) __builtin_amdgcn_mfma_f32_32x32x16_bf16((a), (b), (c), 0, 0, 0)
__device__ __forceinline__ bf16x8 ldg8(const bf16* p) { return *(const GAS bf16x8*)p; }
__device__ __forceinline__ bf16x8 pack_frag(const f32x16& x, int s) {
    u32x4 p; p.x = cvtpk(x[8 * s + 0], x[8 * s + 1]); p.y = cvtpk(x[8 * s + 2], x[8 * s + 3]); p.z = cvtpk(x[8 * s + 4], x[8 * s + 5]); p.w = cvtpk(x[8 * s + 6], x[8 * s + 7]);
    return __builtin_bit_cast(bf16x8, p);
}
__device__ __forceinline__ f32x16 zero16() { f32x16 z;
#pragma unroll
    for (int i = 0; i < 16; ++i) z[i] = 0.f; return z; }

__device__ __forceinline__ void attn_wg_item(int item, unsigned char* ws, LAS unsigned char* lds, int w, int lane) {
    const int g = item >> 9, rem = item & 511, head = rem >> 6, qb = rem & 63;
    const int L = SEQ >> (2 * g), prow0 = qb * 256, q0 = prow0 & (L - 1), r32 = lane & 31, hh = lane >> 5;
    const bf16* Q = (const bf16*)(ws + WS_QA) + (size_t)g * M * 1024 + head * 128 + 8 * hh;
    const bf16* Kg = (const bf16*)(ws + WS_KA) + (size_t)g * M * 1024 + head * 128;
    const bf16* VTg = (const bf16*)(ws + WS_VTG) + (size_t)g * 1024 * M + (size_t)(head * 128) * M;
#define AW_ISSUE(p) do { LAS unsigned char* bufp_ = lds + ((p) & 1) * 65536; const int krow_ = prow0 - 128 + 128 * (p); _Pragma("unroll") for (int i_ = 0; i_ < 4; ++i_) { \
        const int row_ = 4 * (4 * w + i_) + (lane >> 4), pc_ = (lane & 15) ^ (row_ & 15); \
        __builtin_amdgcn_global_load_lds((const unsigned*)(Kg + (size_t)(krow_ + row_) * 1024 + pc_ * 8), (LAS unsigned*)(bufp_ + (4 * w + i_) * 1024), 16, 0, 0); \
        __builtin_amdgcn_global_load_lds((const unsigned*)(VTg + (size_t)row_ * M + krow_ + pc_ * 8), (LAS unsigned*)(bufp_ + 32768 + (4 * w + i_) * 1024), 16, 0, 0); } } while (0)
    const int p0 = q0 >= 128 ? 0 : 1;
    bf16x8 qf[8];
#pragma unroll
    for (int kb = 0; kb < 8; ++kb) qf[kb] = ldg8(Q + (size_t)(prow0 + 32 * w + r32) * 1024 + kb * 16);
    AW_ISSUE(p0);
    f32x16 o[4]; o[0] = zero16(); o[1] = zero16(); o[2] = zero16(); o[3] = zero16();
    float mrun = -1e30f, lrun = 0.f;
    const int kperm = (r32 & ~12) | ((r32 & 4) << 1) | ((r32 & 8) >> 1);
    for (int p = p0; p < 3; ++p) {
        VM_WAIT(); __syncthreads();
        if (p < 2) AW_ISSUE(p + 1);
        asm volatile("" ::: "memory"); __builtin_amdgcn_sched_barrier(0);
        const LAS unsigned char* kb_ = lds + (p & 1) * 65536; const LAS unsigned char* vb_ = kb_ + 32768;
        const int ch_lo = 4 * p > w ? 4 * p : w, ch_hi = 4 * p + 4 < w + 5 ? 4 * p + 4 : w + 5;
        for (int ch = ch_lo; ch < ch_hi; ++ch) {
            const int c = ch - w, cl = ch - 4 * p;
            if (q0 + 32 * w - 128 + 32 * c < 0) continue;
            bf16x8 kf[8];
            { const int krow = cl * 32 + kperm; const LAS unsigned char* kr = kb_ + krow * 256; const int kx = krow & 15;
#pragma unroll
              for (int kb = 0; kb < 8; ++kb) kf[kb] = *(const LAS bf16x8*)(kr + (((2 * kb + hh) ^ kx) << 4)); }
            f32x16 sa = zero16();
#pragma unroll
            for (int kb = 0; kb < 8; ++kb) sa = MFMA32(kf[kb], qf[kb], sa);
            float cm = -1e30f;
#pragma unroll
            for (int i = 0; i < 16; ++i) { const int kap = (i & 7) + 8 * hh + 16 * (i >> 3);
                const bool valid = !((c == 0 && kap < r32) || (c == 4 && kap > r32));
                sa[i] = valid ? sa[i] : -1e30f; cm = fmaxf(cm, sa[i]); }
            cm = fmaxf(cm, __shfl_xor(cm, 32));
            const float mnew = fmaxf(mrun, cm), alpha = fexp2(mrun - mnew);
            float ps = 0.f;
#pragma unroll
            for (int i = 0; i < 16; ++i) { sa[i] = fexp2(sa[i] - mnew); ps += sa[i]; }
            ps += __shfl_xor(ps, 32);
            lrun = lrun * alpha + ps; mrun = mnew;
            const bf16x8 pf0 = pack_frag(sa, 0), pf1 = pack_frag(sa, 1);
            bf16x8 vf[4][2];
#pragma unroll
            for (int eb = 0; eb < 4; ++eb)
#pragma unroll
                for (int s2 = 0; s2 < 2; ++s2) { const int row = eb * 32 + r32; vf[eb][s2] = *(const LAS bf16x8*)(vb_ + row * 256 + (((4 * cl + 2 * s2 + hh) ^ (row & 15)) << 4)); }
#pragma unroll
            for (int eb = 0; eb < 4; ++eb) { o[eb] = o[eb] * alpha; o[eb] = MFMA32(vf[eb][0], pf0, o[eb]); o[eb] = MFMA32(vf[eb][1], pf1, o[eb]); }
        }
    }
    __syncthreads();
    LAS unsigned char* wl = lds + 65536 + w * 8192;
    const float inv = 1.0f / lrun;
#pragma unroll
    for (int eb = 0; eb < 4; ++eb)
#pragma unroll
        for (int a = 0; a < 4; ++a) { u32x2 wv; wv.x = cvtpk(o[eb][4 * a] * inv, o[eb][4 * a + 1] * inv); wv.y = cvtpk(o[eb][4 * a + 2] * inv, o[eb][4 * a + 3] * inv);
            *(LAS u32x2*)(wl + r32 * 256 + (((eb * 4 + a) ^ (r32 & 15)) << 4) + 8 * hh) = wv; }
    LDS_WAIT();
    bf16* OG = (bf16*)(ws + WS_OG) + (size_t)g * M * 1024 + (size_t)(prow0 + 32 * w) * 1024 + head * 128;
#pragma unroll
    for (int j = 0; j < 8; ++j) { const int row = 4 * j + (lane >> 4), pc = (lane & 15) ^ (row & 15);
        const u32x4 v = *(const LAS u32x4*)(wl + row * 256 + ((lane & 15) << 4)); *(GAS u32x4*)(OG + (size_t)row * 1024 + pc * 8) = v; }
    if (hh == 0) ((GAS float*)(ws + WS_LSE))[(size_t)g * M * 8 + (size_t)(prow0 + 32 * w + r32) * 8 + head] = mrun + __builtin_amdgcn_logf(lrun);
    LDS_WAIT(); __syncthreads();
#undef AW_ISSUE
}
__device__ __forceinline__ void p2a_attention(Frame& F, int cw) {
    volatile LAS unsigned* slot = (volatile LAS unsigned*)(F.lds + MISC_OFF + 64);
    for (;;) {
        const int lane = lane_now();
        if (F.wave == 0 && lane == 0) *slot = __hip_atomic_fetch_add((unsigned*)(F.ctl + cw), 1u, RLX_AGENT);
        __syncthreads();
        const unsigned idx = (unsigned)__builtin_amdgcn_readfirstlane((int)*slot);
        __syncthreads();
        if (idx >= 1536u) break;
        attn_wg_item((int)idx, F.ws, F.lds, F.wave, lane);
    }
}

__device__ __forceinline__ void ret_unit(Frame& F, int unit, const float* gn_g) {
    const int b = unit >> 8, h = (unit >> 5) & 7, n = unit & 31, lane = lane_now(), w = F.wave, r32 = lane & 31, hh = lane >> 5;
    unsigned char* ws = F.ws;
    const int tok0 = b * SEQ + n * 128;
    const float lg = LOG2G[h];
    const bf16* QRg = (const bf16*)(ws + WS_QR) + (size_t)tok0 * 2048 + h * 256;
    const bf16* KR = (const bf16*)(ws + WS_KR) + (size_t)tok0 * 2048 + h * 256 + 8 * hh;
    LAS unsigned char* fr = F.lds;
    LAS float* stt = (LAS float*)(F.lds + 20480);
    LAS unsigned char* ql = F.lds + 32768;
    const int kperm = (r32 & ~12) | ((r32 & 4) << 1) | ((r32 & 8) >> 1);
#pragma unroll
    for (int i = 0; i < 8; ++i) { const int row = 2 * (w * 8 + i) + hh, pc = r32 ^ (row & 15);
        __builtin_amdgcn_global_load_lds((const unsigned*)(QRg + (size_t)row * 2048 + pc * 8), (LAS unsigned*)(ql + (w * 8 + i) * 1024), 16, 0, 0); }
    VM_WAIT(); __syncthreads();
#define RU_QFRAG(qb, ks) (*(const LAS bf16x8*)(ql + ((qb) * 32 + r32) * 512 + ((((2 * (ks) + hh)) ^ (r32 & 15)) << 4)))
    for (int k = w; k < 10; k += 8) {
        const int jb = k < 4 ? 0 : (k < 7 ? 1 : (k < 9 ? 2 : 3)), qb = k < 4 ? k : (k < 7 ? k - 3 : (k < 9 ? k - 5 : 3));
        f32x16 x = zero16();
        const bf16* ka = KR + (size_t)(jb * 32 + kperm) * 2048;
        bf16x8 kf[16];
#pragma unroll
        for (int ks = 0; ks < 16; ++ks) kf[ks] = ldg8(ka + ks * 16);
#pragma unroll
        for (int ks = 0; ks < 16; ++ks) x = MFMA32(kf[ks], RU_QFRAG(qb, ks), x);
#pragma unroll
        for (int i = 0; i < 16; ++i) { const int j = jb * 32 + (i & 7) + 8 * hh + 16 * (i >> 3), q = qb * 32 + r32, df = q - j; x[i] = df >= 0 ? x[i] * fexp2((float)df * lg) : 0.f; }
        *(LAS bf16x8*)(fr + ((k * 2 + 0) * 64 + lane) * 16) = pack_frag(x, 0);
        *(LAS bf16x8*)(fr + ((k * 2 + 1) * 64 + lane) * 16) = pack_frag(x, 1);
    }
    __syncthreads();
    f32x16 acc[2][4];
#pragma unroll
    for (int e2 = 0; e2 < 2; ++e2)
#pragma unroll
        for (int qb = 0; qb < 4; ++qb) acc[e2][qb] = zero16();
    if (n > 0) {
        const bf16* ST = (const bf16*)(ws + WS_ST) + ((size_t)(((b * 8 + h) * 32 + n)) * 512 + w * 64 + r32) * 256 + 8 * hh;
        bf16x8 sa[2][4][2];
#pragma unroll
        for (int j = 0; j < 4; ++j) { sa[0][j][0] = ldg8(ST + j * 16); sa[0][j][1] = ldg8(ST + (size_t)32 * 256 + j * 16); }
#pragma unroll
        for (int kb = 0; kb < 4; ++kb) {
            if (kb < 3) {
#pragma unroll
                for (int j = 0; j < 4; ++j) { sa[(kb + 1) & 1][j][0] = ldg8(ST + ((kb + 1) * 4 + j) * 16); sa[(kb + 1) & 1][j][1] = ldg8(ST + (size_t)32 * 256 + ((kb + 1) * 4 + j) * 16); } }
#pragma unroll
            for (int j = 0; j < 4; ++j) { const int ks = kb * 4 + j;
#pragma unroll
                for (int qb = 0; qb < 4; ++qb) { const bf16x8 bq = RU_QFRAG(qb, ks); acc[0][qb] = MFMA32(sa[kb & 1][j][0], bq, acc[0][qb]); acc[1][qb] = MFMA32(sa[kb & 1][j][1], bq, acc[1][qb]); } }
        }
#pragma unroll
        for (int qb = 0; qb < 4; ++qb) { const float sc = fexp2((float)(qb * 32 + r32 + 1) * lg); acc[0][qb] = acc[0][qb] * sc; acc[1][qb] = acc[1][qb] * sc; }
    }
    {
        const bf16* VT = (const bf16*)(ws + WS_VTR) + (size_t)(h * 512 + w * 64 + r32) * M + tok0 + 8 * hh;
#pragma unroll
        for (int jb = 0; jb < 4; ++jb)
#pragma unroll
            for (int s = 0; s < 2; ++s) {
                const bf16x8 a0 = ldg8(VT + jb * 32 + 16 * s), a1 = ldg8(VT + (size_t)32 * M + jb * 32 + 16 * s);
#pragma unroll
                for (int qb = jb; qb < 4; ++qb) { const int k = (jb == 0 ? 0 : (jb == 1 ? 4 : (jb == 2 ? 7 : 9))) + (qb - jb);
                    const bf16x8 p = *(const LAS bf16x8*)(fr + ((k * 2 + s) * 64 + lane) * 16);
                    acc[0][qb] = MFMA32(a0, p, acc[0][qb]); acc[1][qb] = MFMA32(a1, p, acc[1][qb]); }
            }
    }
#pragma unroll
    for (int qb = 0; qb < 4; ++qb) { float s1 = 0.f, s2 = 0.f;
#pragma unroll
        for (int e2 = 0; e2 < 2; ++e2)
#pragma unroll
            for (int i = 0; i < 16; ++i) { const float v = acc[e2][qb][i]; s1 += v; s2 += v * v; }
        s1 += __shfl_xor(s1, 32); s2 += __shfl_xor(s2, 32);
        if (hh == 0) { stt[((qb * 32 + r32) * 8 + w) * 2] = s1; stt[((qb * 32 + r32) * 8 + w) * 2 + 1] = s2; } }
    __syncthreads();
    const float* gp = gn_g + h * 512 + w * 64 + 4 * hh;
#pragma unroll
    for (int qb = 0; qb < 4; ++qb) { float s1 = 0.f, s2 = 0.f;
#pragma unroll
        for (int ww = 0; ww < 8; ++ww) { s1 += stt[((qb * 32 + r32) * 8 + ww) * 2]; s2 += stt[((qb * 32 + r32) * 8 + ww) * 2 + 1]; }
        const float mu = s1 * (1.0f / 512.0f), var = fmaxf(s2 * (1.0f / 512.0f) - mu * mu, 0.f), rstd = 1.0f / sqrtf(var + GN_EPS);
        const size_t ro = (size_t)(tok0 + qb * 32 + r32) * D + h * 512 + w * 64 + 4 * hh;
        const bf16* gr = (const bf16*)(ws + WS_GR) + ro; bf16* og = (bf16*)(ws + WS_RG) + ro;
#pragma unroll
        for (int e2 = 0; e2 < 2; ++e2)
#pragma unroll
            for (int a = 0; a < 4; ++a) { const f32x4 gg = *(const GAS f32x4*)(gp + e2 * 32 + 8 * a); const u32x2 sg = *(const GAS u32x2*)(gr + e2 * 32 + 8 * a);
                const float v0 = (acc[e2][qb][4 * a] - mu) * rstd * gg[0] * bflo(sg.x), v1 = (acc[e2][qb][4 * a + 1] - mu) * rstd * gg[1] * bfhi(sg.x);
                const float v2 = (acc[e2][qb][4 * a + 2] - mu) * rstd * gg[2] * bflo(sg.y), v3 = (acc[e2][qb][4 * a + 3] - mu) * rstd * gg[3] * bfhi(sg.y);
                u32x2 wv; wv.x = cvtpk(v0, v1); wv.y = cvtpk(v2, v3); *(GAS u32x2*)(og + e2 * 32 + 8 * a) = wv; } }
    __syncthreads();
}
#undef RU_QFRAG
__device__ __forceinline__ void combine_token(unsigned char* ws, int t, int lane) {
    const int b = t >> 12, sp = t & (SEQ - 1), head = lane >> 3;
    float lse[3]; size_t prow[3];
#pragma unroll
    for (int g = 0; g < 3; ++g) { const int sh = 2 * g, d = 1 << sh, L = SEQ >> sh; prow[g] = (size_t)(b * d + (sp & (d - 1))) * L + (sp >> sh);
        lse[g] = ((const GAS float*)(ws + WS_LSE))[(size_t)g * M * 8 + prow[g] * 8 + head]; }
    const float mx = fmaxf(lse[0], fmaxf(lse[1], lse[2]));
    float wg[3], ws_ = 0.f;
#pragma unroll
    for (int g = 0; g < 3; ++g) { wg[g] = fexp2(lse[g] - mx); ws_ += wg[g]; }
    const float inv = 1.0f / ws_;
    f32x4 o[4];
#pragma unroll
    for (int j = 0; j < 4; ++j) o[j] = (f32x4){0.f, 0.f, 0.f, 0.f};
#pragma unroll
    for (int g = 0; g < 3; ++g) { const bf16* og = (const bf16*)(ws + WS_OG) + (size_t)g * M * 1024 + prow[g] * 1024 + lane * 16;
        const u32x4 w0 = *(const GAS u32x4*)og, w1 = *(const GAS u32x4*)(og + 8); f32x4 a0, a1, a2, a3; ge::unpack8(w0, a0, a1); ge::unpack8(w1, a2, a3);
        const float f = wg[g] * inv; o[0] += a0 * f; o[1] += a1 * f; o[2] += a2 * f; o[3] += a3 * f; }
    bf16* oa = (bf16*)(ws + WS_OATT) + (size_t)t * 1024 + lane * 16;
    *(GAS u32x4*)oa = ge::pack8(o[0], o[1]); *(GAS u32x4*)(oa + 8) = ge::pack8(o[2], o[3]);
}
__device__ __forceinline__ void p2b_phase(Frame& F, const float* gn_g) {
    for (int u = F.c; u < 1024; u += F.G) ret_unit(F, u, gn_g);
    const int gw = F.c * NWAVES + F.wave, NGW = F.G * NWAVES;
    { const int lane = lane_now(); for (int t = gw; t < M; t += NGW) combine_token(F.ws, t, lane); }
}

template <int MODE>
__device__ __forceinline__ void lnb_rows(Frame& F, const bf16* src, float* dstf, bf16* dstb, unsigned char* dst8, float* stat, const float* gam, const float* bet) {
    const int gw = F.c * NWAVES + F.wave, NGW = F.G * NWAVES, lane = lane_now();
    if (MODE == 1 && gw < D / 64) { const int col = gw * 64 + lane; ((GAS f32x2_t*)stat)[M + col] = (f32x2_t){ALPHA * gam[col], ALPHA * bet[col]}; }
    for (int m = gw; m < M; m += NGW) {
        const GAS u32x4* xr = (const GAS u32x4*)(src + (size_t)m * D) + lane;
        f32x4 v[16]; float s = 0.f;
#pragma unroll
        for (int j = 0; j < 8; ++j) { const u32x4 w = xr[64 * j]; ge::unpack8(w, v[2 * j], v[2 * j + 1]);
            s += ((v[2 * j][0] + v[2 * j][1]) + (v[2 * j][2] + v[2 * j][3])) + ((v[2 * j + 1][0] + v[2 * j + 1][1]) + (v[2 * j + 1][2] + v[2 * j + 1][3])); }
        const float mean = wave_sum(s) * (1.0f / D); float s2 = 0.f;
#pragma unroll
        for (int j = 0; j < 16; ++j) { v[j] = v[j] - mean; s2 += (v[j][0] * v[j][0] + v[j][1] * v[j][1]) + (v[j][2] * v[j][2] + v[j][3] * v[j][3]); }
        const float rstd = 1.0f / sqrtf(wave_sum(s2) * (1.0f / D) + LN_EPS);
        if (MODE == 1 && lane == 0) ((GAS f32x2_t*)stat)[m] = (f32x2_t){mean, rstd};
        GAS f32x4* of = (GAS f32x4*)(dstf + (size_t)m * D) + 2 * lane;
        GAS u32x4* ob = (GAS u32x4*)(dstb + (size_t)m * D) + lane;
        GAS u32x2* o8 = (GAS u32x2*)(dst8 + (size_t)m * D) + lane;
#pragma unroll
        for (int j = 0; j < 8; ++j) { const GAS f32x4* gp = (const GAS f32x4*)gam + 2 * (lane + 64 * j); const GAS f32x4* bp = (const GAS f32x4*)bet + 2 * (lane + 64 * j);
            const f32x4 y0 = v[2 * j] * rstd * gp[0] + bp[0], y1 = v[2 * j + 1] * rstd * gp[1] + bp[1];
            if (MODE == 1) { ob[64 * j] = ge::pack8(y0, y1); u32x2 w8; w8.x = pk_fp8x4(y0[0], y0[1], y0[2], y0[3]); w8.y = pk_fp8x4(y1[0], y1[1], y1[2], y1[3]); o8[64 * j] = w8; }
            else { of[128 * j] = y0; of[128 * j + 1] = y1; } }
    }
}

__device__ __forceinline__ void kpt_transpose(Frame& F) {
    const int lane = lane_now(), gw = F.c * NWAVES + F.wave, NGW = F.G * NWAVES;
    LAS unsigned short* scr = (LAS unsigned short*)(F.lds + F.wave * 16384);
    const bf16* KR = (const bf16*)(F.ws + WS_KR); bf16* KT = (bf16*)(F.ws + WS_KPT);
    for (int it = gw; it < (M / 64) * (2048 / 64); it += NGW) {
        const int tb = it >> 5, fb = it & 31, tok0 = tb * 64, f0 = fb * 64, h = fb >> 2;
#pragma unroll
        for (int i = 0; i < 8; ++i) { const int r = 8 * i + (lane >> 3), cpos = (lane & 7) * 8;
            const u32x4 v = *(const GAS u32x4*)(KR + (size_t)(tok0 + r) * 2048 + f0 + cpos);
            LAS unsigned* d = (LAS unsigned*)(scr + r * 66 + cpos); d[0] = v.x; d[1] = v.y; d[2] = v.z; d[3] = v.w; }
        LDS_WAIT(); asm volatile("" ::: "memory");
        const float lg = LOG2G[h]; const int tpos = (lane & 7) * 8;
        float dec[8];
#pragma unroll
        for (int j = 0; j < 8; ++j) dec[j] = fexp2((float)(127 - ((tok0 + tpos + j) & 127)) * lg);
#pragma unroll
        for (int i = 0; i < 8; ++i) { const int f = 8 * i + (lane >> 3); float v[8];
#pragma unroll
            for (int j = 0; j < 8; ++j) v[j] = __uint_as_float((unsigned)scr[(tpos + j) * 66 + f] << 16) * dec[j];
            u32x4 o; o.x = cvtpk(v[0], v[1]); o.y = cvtpk(v[2], v[3]); o.z = cvtpk(v[4], v[5]); o.w = cvtpk(v[6], v[7]);
            *(GAS u32x4*)(KT + (size_t)(f0 + f) * M + tok0 + tpos) = o; }
        LDS_WAIT(); asm volatile("" ::: "memory");
    }
}

__global__ void __launch_bounds__(NWAVES * 64, 2) mk_fwd(Args args) {
    extern __shared__ __attribute__((aligned(16))) unsigned char lds[];
    Frame F;
    F.lds = (LAS unsigned char*)lds;
    F.wave = __builtin_amdgcn_readfirstlane((int)(threadIdx.x >> 6));
    F.G = gridDim.x; F.c = blockIdx.x; F.ws = args.ws;
    F.ctl = (gu32*)(args.ws + WS_CTL);
    volatile LAS unsigned* MISC = (volatile LAS unsigned*)(F.lds + MISC_OFF);
    for (int u = threadIdx.x; u < (LDS_BYTES - LDSCTL_OFF) / 4; u += NWAVES * 64) ((LAS unsigned*)(F.lds + LDSCTL_OFF))[u] = 0u;
    __syncthreads();
    XcdBarrier bar; bar.bar = (unsigned*)(F.ctl + CW_BAR); bar.x = 0; bar.st = nullptr; bar.wave = F.wave;
    if (MK_N_LAUNCHES == 1) bar = xcd_barrier_post((unsigned*)(F.ctl + CW_BAR), MISC + 8, F.wave);
    const int lo = args.ph_lo, hi = args.ph_hi;
#ifndef ST_MASK
#define ST_MASK 0xff
#endif
#define SM(k) ((ST_MASK >> (k)) & 1)
#ifndef DUP_MASK
#define DUP_MASK 0
#endif
#define DUP(k) ((DUP_MASK >> (k)) & 1)
#ifndef PH_MASK
#define PH_MASK 0x7ff
#endif
#define IN(k) (((PH_MASK >> (k)) & 1) && lo <= (k) && (k) < hi)
#define SEAM(k) do { if (IN(k) && IN((k) + 1)) xcd_barrier(bar); } while (0)

    if (IN(0)) { p0_prologue(F, args); if (DUP(0)) { xcd_barrier(bar); p0_prologue(F, args); } SEAM(0); }
    const unsigned* utab = (const unsigned*)(args.ws + WS_TAB) + (size_t)F.c * NSLOT * ge::GU_DW;
#define UT(slot) (utab + (slot) * ge::GU_DW)
    if (IN(1)) {
        ge::gemm_stream<ge::K_SCALE, 0, true>(F.lds, UT(SL_P1), 9, F.wave);
        ge::gemm_stream<ge::K_SCALE, 0>(F.lds, UT(SL_P1 + 9), 4, F.wave);
        ge::gemm_stream<ge::K_ROT, 0>(F.lds, UT(SL_P1B), 4, F.wave);
        ge::gemm_stream<ge::K_SILU, 0>(F.lds, UT(SL_P1D), 4, F.wave);
        ge::gemm_stream<ge::K_SIG, 0, true>(F.lds, UT(SL_P1E), 8 - GX, F.wave);
        if (DUP(1)) { xcd_barrier(bar); ge::gemm_stream<ge::K_SCALE, 0, true>(F.lds, UT(SL_P1), 9, F.wave); ge::gemm_stream<ge::K_SCALE, 0>(F.lds, UT(SL_P1 + 9), 4, F.wave); ge::gemm_stream<ge::K_ROT, 0>(F.lds, UT(SL_P1B), 4, F.wave); ge::gemm_stream<ge::K_SILU, 0>(F.lds, UT(SL_P1D), 4, F.wave); ge::gemm_stream<ge::K_SIG, 0, true>(F.lds, UT(SL_P1E), 8 - GX, F.wave); }
        SEAM(1); }
    if (IN(2)) { kpt_transpose(F); if (DUP(2)) { xcd_barrier(bar); kpt_transpose(F); } SEAM(2); }
    if (IN(3)) { ge::gemm_stream<ge::K_SCALE, 2>(F.lds, UT(SL_SCAN), 31, F.wave); ge::gemm_stream<ge::K_SIG, 0, true>(F.lds, UT(SL_G2), 2 * GX, F.wave); late_weights_queue(F, args, CW_WORK + 64); p2a_attention(F, CW_WORK); if (DUP(11)) { xcd_barrier(bar); p2a_attention(F, CW_WORK + 128); } if (DUP(12)) { xcd_barrier(bar); late_weights_queue(F, args, CW_WORK + 192); } if (DUP(3)) { xcd_barrier(bar); ge::gemm_stream<ge::K_SCALE, 2>(F.lds, UT(SL_SCAN), 31, F.wave); } SEAM(3); }
    if (IN(4)) { p2b_phase(F, args.in[5]); if (DUP(4)) { xcd_barrier(bar); p2b_phase(F, args.in[5]); } SEAM(4); }
    if (IN(5)) { ge::gemm_stream<ge::K_SCALE, 0>(F.lds, UT(SL_P3), 4, F.wave); ge::gemm_stream<ge::K_FIN, 1>(F.lds, UT(SL_P3B), 8, F.wave); if (DUP(5)) { xcd_barrier(bar); ge::gemm_stream<ge::K_SCALE, 0>(F.lds, UT(SL_P3), 4, F.wave); ge::gemm_stream<ge::K_FIN, 1>(F.lds, UT(SL_P3B), 8, F.wave); } SEAM(5); }
    if (IN(6)) { ge::gemm_stream<ge::K_WO, 0>(F.lds, UT(SL_P4), 4, F.wave); if (DUP(6)) { xcd_barrier(bar); ge::gemm_stream<ge::K_WO, 0>(F.lds, UT(SL_P4), 4, F.wave); } SEAM(6); }
    if (IN(7)) { lnb_rows<1>(F, (const bf16*)(args.ws + WS_P1B), nullptr, (bf16*)(args.ws + WS_H1B), args.ws + WS_X8, (float*)(args.ws + WS_STAT), args.in[7], args.in[8]); if (DUP(7)) { xcd_barrier(bar); lnb_rows<1>(F, (const bf16*)(args.ws + WS_P1B), nullptr, (bf16*)(args.ws + WS_H1B), args.ws + WS_X8, (float*)(args.ws + WS_STAT), args.in[7], args.in[8]); } SEAM(7); }
    if (IN(8)) { ge::gemm_stream<ge::K_SWIGLU, 0>(F.lds, UT(SL_P5), 22, F.wave); if (DUP(8)) { xcd_barrier(bar); ge::gemm_stream<ge::K_SWIGLU, 0>(F.lds, UT(SL_P5), 22, F.wave); } ge::gemm_stream<ge::K_PLE, 0, true>(F.lds, UT(SL_P5B), 5, F.wave); SEAM(8); }
    if (IN(9)) { ge::gemm_stream<ge::K_DOWN, 0, false, true>(F.lds, UT(SL_P6), 4, F.wave); if (DUP(9)) { xcd_barrier(bar); ge::gemm_stream<ge::K_DOWN, 0>(F.lds, UT(SL_P6), 4, F.wave); } SEAM(9); }
    if (IN(10)) { lnb_rows<0>(F, (const bf16*)(args.ws + WS_P2B), args.out, nullptr, nullptr, nullptr, args.in[14], args.in[15]); }
#undef IN
#undef SEAM
}

extern "C" void kernel_launch(void* const* d_in, const int* in_sizes, int n_in, void* d_out, int out_size, void* d_ws, size_t ws_size, hipStream_t stream) {
    static int grid = 0;
    if (grid == 0) {
        if (n_in != 16 || out_size != M * D || ws_size < WS_END) { fprintf(stderr, "kernel_launch: unexpected problem (n_in %d, out %d, ws %zu); nothing launched\n", n_in, out_size, ws_size); grid = -1; return; }
        int dev = 0, cus = 0;
        if (hipGetDevice(&dev) != hipSuccess || hipDeviceGetAttribute(&cus, hipDeviceAttributeMultiprocessorCount, dev) != hipSuccess) { grid = -1; return; }
        if (hipFuncSetAttribute((const void*)mk_fwd, hipFuncAttributeMaxDynamicSharedMemorySize, LDS_BYTES) != hipSuccess) { fprintf(stderr, "kernel_launch: hipFuncSetAttribute failed\n"); grid = -1; return; }
        int per_cu = 0;
        if (hipOccupancyMaxActiveBlocksPerMultiprocessor(&per_cu, (const void*)mk_fwd, NWAVES * 64, LDS_BYTES) != hipSuccess || per_cu < 1) fprintf(stderr, "kernel_launch: occupancy query reports %d\n", per_cu);
        (void)hipGetLastError();
        grid = cus;
        if (grid != 256) { fprintf(stderr, "kernel_launch: built for 256 CUs, device has %d\n", grid); }
    }
    if (grid < 0) return;
    (void)hipMemsetAsync((char*)d_ws + WS_CTL, 0, CTL_ZERO_BYTES, stream);
    Args a{};
    for (int i = 0; i < 16; ++i) a.in[i] = (const float*)d_in[i];
    a.out = (float*)d_out; a.ws = (unsigned char*)d_ws;
    if (MK_N_LAUNCHES == 1) { a.ph_lo = 0; a.ph_hi = N_PHASES; hipLaunchKernelGGL(mk_fwd, dim3(grid), dim3(NWAVES * 64), LDS_BYTES, stream, a); }
    else for (int p = 0; p < N_PHASES; ++p) { a.ph_lo = p; a.ph_hi = p + 1; hipLaunchKernelGGL(mk_fwd, dim3(grid), dim3(NWAVES * 64), LDS_BYTES, stream, a); }
}
```

```cpp
#include <hip/hip_runtime.h>
#include <cstdio>
#include <cstdint>

#ifndef MK_N_LAUNCHES
#define MK_N_LAUNCHES 1
#endif
constexpr int N_PHASES = 11;

#define GAS __attribute__((address_space(1)))
#define LAS __attribute__((address_space(3)))
typedef unsigned short bf16;
typedef short bf16x8 __attribute__((ext_vector_type(8)));
typedef float f32x4 __attribute__((ext_vector_type(4)));
typedef float f32x16 __attribute__((ext_vector_type(16)));
typedef unsigned u32x4 __attribute__((ext_vector_type(4)));
typedef unsigned u32x2 __attribute__((ext_vector_type(2)));
typedef __bf16 bf16x2_t __attribute__((ext_vector_type(2)));
typedef float f32x2_t __attribute__((ext_vector_type(2)));
typedef GAS unsigned gu32;
#define RLX_AGENT __ATOMIC_RELAXED, __HIP_MEMORY_SCOPE_AGENT
#define LDS_WAIT() asm volatile("s_waitcnt lgkmcnt(0)" ::: "memory")
#define VM_WAIT() asm volatile("s_waitcnt vmcnt(0)" ::: "memory")

constexpr int M = 16384, D = 4096, SEQ = 4096, PLE = 256, FF = 11008, NIN = 29696;
constexpr float ALPHA = 1.189207115002721f;
constexpr float QSCALE = 0.12751743082459868f;
constexpr float LN_EPS = 1e-5f, GN_EPS = 1e-6f;
__device__ const float LOG2G[8] = {-4.580368961312e-02f, -2.272007650008e-02f, -1.131531322783e-02f, -5.646563141142e-03f, -2.820519062379e-03f, -1.409570254671e-03f, -7.046129765894e-04f, -3.522634716290e-04f};
__device__ const float INVF[128] = {
1.000000000e+00f, 9.305720329e-01f, 8.659643531e-01f, 8.058421612e-01f, 7.498942614e-01f, 6.978306174e-01f, 6.493816376e-01f, 6.042963862e-01f, 5.623413324e-01f, 5.232990980e-01f, 4.869675338e-01f, 4.531583786e-01f, 4.216965139e-01f, 3.924189806e-01f, 3.651741147e-01f, 3.398208320e-01f, 3.162277639e-01f, 2.942726910e-01f, 2.738419771e-01f, 2.548296750e-01f, 2.371373773e-01f, 2.206734121e-01f, 2.053525001e-01f, 1.910953075e-01f, 1.778279394e-01f, 1.654817164e-01f, 1.539926529e-01f, 1.433012486e-01f, 1.333521307e-01f, 1.240937784e-01f, 1.154782027e-01f, 1.074607819e-01f, 1.000000015e-01f, 9.305720776e-02f, 8.659642935e-02f, 8.058421314e-02f, 7.498941571e-02f, 6.978306174e-02f, 6.493816525e-02f, 6.042964011e-02f, 5.623413250e-02f, 5.232991278e-02f, 4.869675264e-02f, 4.531583562e-02f, 4.216965288e-02f, 3.924189508e-02f, 3.651741147e-02f, 3.398208320e-02f, 3.162277490e-02f, 2.942727134e-02f, 2.738419734e-02f, 2.548296750e-02f, 2.371373773e-02f, 2.206734009e-02f, 2.053525113e-02f, 1.910952851e-02f, 1.778279431e-02f, 1.654816978e-02f, 1.539926510e-02f, 1.433012541e-02f, 1.333521493e-02f, 1.240937784e-02f, 1.154782064e-02f, 1.074607857e-02f, 9.999999776e-03f, 9.305720218e-03f, 8.659643121e-03f, 8.058422245e-03f, 7.498941850e-03f, 6.978305988e-03f, 6.493816152e-03f, 6.042963825e-03f, 5.623413250e-03f, 5.232991185e-03f, 4.869675264e-03f, 4.531583283e-03f, 4.216964822e-03f, 3.924189601e-03f, 3.651741194e-03f, 3.398208413e-03f, 3.162277630e-03f, 2.942727180e-03f, 2.738419687e-03f, 2.548296936e-03f, 2.371373586e-03f, 2.206734149e-03f, 2.053524833e-03f, 1.910952968e-03f, 1.778279431e-03f, 1.654817141e-03f, 1.539926510e-03f, 1.433012541e-03f, 1.333521446e-03f, 1.240937738e-03f, 1.154781901e-03f, 1.074607833e-03f, 1.000000047e-03f, 9.305720450e-04f, 8.659643354e-04f, 8.058421663e-04f, 7.498942432e-04f, 6.978305755e-04f, 6.493816618e-04f, 6.042963942e-04f, 5.623413017e-04f, 5.232990952e-04f, 4.869675322e-04f, 4.531583691e-04f, 4.216965172e-04f, 3.924189659e-04f, 3.651741426e-04f, 3.398208355e-04f, 3.162277571e-04f, 2.942727006e-04f, 2.738419571e-04f, 2.548296761e-04f, 2.371373703e-04f, 2.206734061e-04f, 2.053525095e-04f, 1.910952997e-04f, 1.778279402e-04f, 1.654817170e-04f, 1.539926452e-04f, 1.433012512e-04f, 1.333521504e-04f, 1.240937709e-04f, 1.154782003e-04f, 1.074607862e-04f};

constexpr size_t MiB = 1u << 20;
constexpr size_t WS_CTL = 0, CTL_ZERO_BYTES = 1 * MiB;
constexpr size_t WS_TAB = 1 * MiB;
constexpr size_t WS_WAO = 4 * MiB, WS_WRO = 12 * MiB, WS_WO = 44 * MiB, WS_WGU = 76 * MiB, WS_WD = 248 * MiB, WS_WPG = 334 * MiB, WS_WPU = 366 * MiB;
constexpr size_t WS_PB = 368 * MiB, WS_WIN = 376 * MiB, WS_XB = 608 * MiB;
constexpr size_t WS_QA = 736 * MiB, WS_KA = 832 * MiB, WS_VTG = 928 * MiB, WS_QR = 1024 * MiB, WS_KR = 1088 * MiB, WS_KPT = 1152 * MiB, WS_VTR = 1216 * MiB,
                 WS_GR = 1344 * MiB, WS_GA = 1472 * MiB, WS_GRT = 1600 * MiB;
constexpr size_t WS_ST = 376 * MiB, WS_OG = 632 * MiB, WS_LSE = 728 * MiB;
constexpr size_t WS_OATT = 736 * MiB, WS_RG = 768 * MiB;
constexpr size_t WS_MIX = 896 * MiB, WS_T = 1024 * MiB;
constexpr size_t WS_STAT = 1152 * MiB, WS_H1B = 1408 * MiB;
constexpr size_t WS_HID = 376 * MiB;
constexpr size_t WS_X8 = 1728 * MiB;
constexpr size_t WS_P1B = 736 * MiB;
constexpr size_t WS_P2B = 896 * MiB;
constexpr size_t WS_WG8 = 1792 * MiB;
constexpr size_t WS_END = 1824 * MiB;
static_assert(WS_OG + 96 * MiB <= WS_LSE && WS_LSE + 2 * MiB <= WS_QA && WS_RG + 128 * MiB <= WS_MIX && WS_T + 128 * MiB <= WS_STAT && WS_H1B + 128 * MiB <= WS_END && WS_HID + 344 * MiB <= WS_OATT && WS_GRT + 128 * MiB <= WS_X8 && WS_X8 + 64 * MiB <= WS_WG8 && WS_WG8 + 32 * MiB <= WS_END && WS_HID + 344 * MiB <= WS_P1B && WS_P1B + 128 * MiB <= WS_P2B && WS_P2B + 128 * MiB <= WS_T, "d_ws map");
constexpr int CW_TMO = 0, CW_WORK = 64;
constexpr int CW_BAR = 4096;

constexpr int RING_BYTES = 131072;
constexpr int LDSCTL_OFF = RING_BYTES, MISC_OFF = LDSCTL_OFF + 320;
constexpr int LDS_BYTES = 147456;
constexpr int NWAVES = 8;

__device__ __forceinline__ unsigned cvtpk(float lo, float hi) { f32x2_t v = {lo, hi}; bf16x2_t b = __builtin_convertvector(v, bf16x2_t); return __builtin_bit_cast(unsigned, b); }
__device__ __forceinline__ unsigned pk_fp8x4(float a, float b, float c, float d) { int w = __builtin_amdgcn_cvt_pk_fp8_f32(a, b, 0, false); w = __builtin_amdgcn_cvt_pk_fp8_f32(c, d, w, true); return (unsigned)w; }
__device__ __forceinline__ float bflo(unsigned w) { return __uint_as_float(w << 16); }
__device__ __forceinline__ float bfhi(unsigned w) { return __uint_as_float(w & 0xffff0000u); }
__device__ __forceinline__ float fexp2(float x) { return __builtin_amdgcn_exp2f(x); }
__device__ __forceinline__ float frcp(float x) { return __builtin_amdgcn_rcpf(x); }
__device__ __forceinline__ float sigmoidf_(float x) { return frcp(1.0f + fexp2(-1.4426950408889634f * x)); }
__device__ __forceinline__ float siluf_(float x) { return x * sigmoidf_(x); }
__device__ __forceinline__ void sincos_pos(float a, float& s, float& c) {
    const float k = rintf(a * 0.15915494309189535f);
    float r = fmaf(-k, 6.28125f, a);
    r = fmaf(-k, 1.935307179586232e-3f, r);
    const float rv = r * 0.15915494309189535f;
    s = __builtin_amdgcn_sinf(rv); c = __builtin_amdgcn_cosf(rv);
}
__device__ __forceinline__ int lane_now() { int l; asm volatile("v_mbcnt_lo_u32_b32 %0, -1, 0\n\tv_mbcnt_hi_u32_b32 %0, -1, %0" : "=v"(l)); return l; }
__device__ __forceinline__ float wave_sum(float v) {
#pragma unroll
    for (int o = 1; o < 64; o <<= 1) v += __shfl_xor(v, o);
    return v;
}

#define XB_TMO      128
#define XB_XCNT(j)  (256  + 64 * (j))
#define XB_XSUB(j)  (1280 + 64 * (j))
#define XB_XGEN(j)  (2304 + 64 * (j))
#define XB_TOP      3328
#define XB_TOPGEN   3392
#define XCD_BAR_WORDS 3456
#define XB_SPIN_CAP (1u << 18)
__device__ __forceinline__ unsigned xb_ld(unsigned* p)              { return __hip_atomic_load(p, __ATOMIC_RELAXED, __HIP_MEMORY_SCOPE_AGENT); }
__device__ __forceinline__ unsigned xb_add(unsigned* p, unsigned v) { return __hip_atomic_fetch_add(p, v, __ATOMIC_RELAXED, __HIP_MEMORY_SCOPE_AGENT); }
__device__ __forceinline__ unsigned xb_xcc_id() { return (unsigned)__builtin_amdgcn_s_getreg((3 << 11) | 20) & 0xFu; }
#define XB_SPIN(cond, bar) do { unsigned _sp = 0; while (cond) { __builtin_amdgcn_s_sleep(1); \
    if ((++_sp & 255u) == 0u) { if (xb_ld(&(bar)[XB_TMO])) break; if (_sp > XB_SPIN_CAP) { atomicAdd(&(bar)[XB_TMO], 1u); break; } } } } while (0)
struct XcdBarrier { unsigned* bar; unsigned x; volatile LAS unsigned* st; int wave; };
__device__ __forceinline__ XcdBarrier xcd_barrier_post(unsigned* bar, volatile LAS unsigned* st, int wave) {
    XcdBarrier b; b.bar = bar; b.x = xb_xcc_id(); b.st = st; b.wave = wave;
    if (wave == 0 && lane_now() == 0) (void)xb_add(&bar[XB_XCNT(b.x)], 1u);
    return b;
}
__device__ __forceinline__ void xcd_barrier_complete(unsigned* bar, unsigned x, unsigned& nloc, unsigned& nx) {
    const unsigned G = gridDim.x * gridDim.y * gridDim.z;
    unsigned sum, cnt, mine, sp = 0u;
    for (;;) {
        sum = 0u; cnt = 0u; mine = 0u;
#pragma unroll
        for (unsigned j = 0; j < 16; ++j) { const unsigned c = xb_ld(&bar[XB_XCNT(j)]); sum += c; cnt += (c > 0u) ? 1u : 0u; mine = (j == x) ? c : mine; }
        if (sum == G) break;
        __builtin_amdgcn_s_sleep(1);
        if ((++sp & 255u) == 0u) { if (xb_ld(&bar[XB_TMO])) break; if (sp > XB_SPIN_CAP) { atomicAdd(&bar[XB_TMO], 1u); break; } }
    }
    nloc = mine > 0u ? mine : 1u; nx = cnt > 0u ? cnt : 1u;
}
__device__ __forceinline__ void xcd_barrier(const XcdBarrier& b) {
    asm volatile("s_waitcnt vmcnt(0)" ::: "memory");
    __syncthreads();
    if (b.wave == 0 && lane_now() == 0) {
        unsigned* bar = b.bar;
        __builtin_amdgcn_s_waitcnt(0);
        unsigned nloc = b.st[0], nx = b.st[1];
        if (nloc == 0u) { xcd_barrier_complete(bar, b.x, nloc, nx); b.st[0] = nloc; b.st[1] = nx; }
        const unsigned old = xb_add(&bar[XB_XSUB(b.x)], 1u);
        const unsigned gen = old / nloc;
        if (old + 1u == (gen + 1u) * nloc) {
            __builtin_amdgcn_fence(__ATOMIC_RELEASE, "agent");
            asm volatile("s_waitcnt vmcnt(0)" ::: "memory");
            const unsigned og = xb_add(&bar[XB_TOP], 1u);
            const unsigned tg = og / nx;
            if (og + 1u == (tg + 1u) * nx) xb_add(&bar[XB_TOPGEN], 1u);
            else XB_SPIN(xb_ld(&bar[XB_TOPGEN]) == tg, bar);
            __builtin_amdgcn_fence(__ATOMIC_ACQUIRE, "agent");
            xb_add(&bar[XB_XGEN(b.x)], 1u);
            asm volatile("s_waitcnt vmcnt(0)" ::: "memory");
        } else {
            XB_SPIN(xb_ld(&bar[XB_XGEN(b.x)]) == gen, bar);
            __builtin_amdgcn_fence(__ATOMIC_ACQUIRE, "agent");
            asm volatile("s_waitcnt vmcnt(0)" ::: "memory");
        }
    }
    __syncthreads();
}

namespace ge {
constexpr int BM = 256, BK = 64, HALF = 128, HTB = HALF * BK * 2, STAGE_BYTES = 8 * HTB;
__host__ __device__ __forceinline__ int lds_byte(int r, int c) { const int st = (r >> 4) * 2 + (c >> 5), rr = r & 15, cc = c & 31, ob = rr * 64 + cc * 2; return st * 1024 + (ob ^ (((ob >> 9) & 1) << 5)); }
__host__ __device__ __forceinline__ void stage_rc(int b, int& R, int& C) { const int st = b / 1024, sb = b % 1024, swz = sb ^ (((sb >> 9) & 1) << 5); R = (st >> 1) * 16 + swz / 64; C = (st & 1) * 32 + (swz % 64) / 2; }
__host__ __device__ __forceinline__ int perm32(int rho) { const int n = rho >> 4, i = rho & 15; return 8 * (i >> 2) + 4 * n + (i & 3); }

enum Kind { K_SCALE = 0, K_ROT = 1, K_ROTT = 2, K_SILU = 3, K_SIG = 4, K_MID = 5, K_FIN = 6, K_WO = 7, K_SWIGLU = 8, K_PLE = 9, K_DOWN = 10 };
struct GU {
    const char* A; const char* B;
    char* out;
    const char* x0; const char* x1;
    unsigned sA, sB;
    int nt;
    unsigned ldo, ldx;
    int i0, i1;
    int pad[3];
};
static_assert(sizeof(GU) == 80, "unit table entry");
constexpr int GU_DW = 20;
__device__ __forceinline__ void tile_of(int local, int nM, int nN, int& pm, int& pn) {
    const int nwg = nM * nN; int wgid = local;
    { const int q = nwg / 8, r = nwg % 8, xcd = wgid % 8, off = wgid / 8; wgid = (xcd < r ? xcd * (q + 1) : r * (q + 1) + (xcd - r) * q) + off; }
    const int nig = 8 * nN, gid = wgid / nig, fm = gid * 8, gsz = (nM - fm) < 8 ? (nM - fm) : 8;
    pm = fm + ((wgid % nig) % gsz); pn = (wgid % nig) / gsz;
}

typedef f32x4 Acc[2][2][4][2];
#define EPI_FENCE() do { asm volatile("" ::: "memory"); __builtin_amdgcn_sched_barrier(0); } while (0)
__device__ __forceinline__ u32x4 pack8(const f32x4 a, const f32x4 b) { u32x4 w; w.x = cvtpk(a[0], a[1]); w.y = cvtpk(a[2], a[3]); w.z = cvtpk(b[0], b[1]); w.w = cvtpk(b[2], b[3]); return w; }
__device__ __forceinline__ void unpack8(const u32x4 w, f32x4& a, f32x4& b) { a = (f32x4){bflo(w.x), bfhi(w.x), bflo(w.y), bfhi(w.y)}; b = (f32x4){bflo(w.z), bfhi(w.z), bflo(w.w), bfhi(w.w)}; }

template <int MODE>
__device__ __forceinline__ void epi_bf16(Acc& acc, const GU& u, int r0, int c0) {
    const float f = __int_as_float(u.i0);
#pragma unroll
    for (int ai = 0; ai < 2; ++ai)
#pragma unroll
        for (int m = 0; m < 4; ++m) { EPI_FENCE(); char* rowp = u.out + (size_t)(r0 + ai * 128 + m * 16) * u.ldo + (size_t)c0 * 2;
#pragma unroll
            for (int bj = 0; bj < 2; ++bj) { const f32x4 a0 = acc[ai][bj][m][0], a1 = acc[ai][bj][m][1]; f32x4 v0, v1;
                if (MODE == 0) { v0 = a0 * f; v1 = a1 * f; }
                else if (MODE == 1) { v0 = (f32x4){siluf_(a0[0] * f), siluf_(a0[1] * f), siluf_(a0[2] * f), siluf_(a0[3] * f)}; v1 = (f32x4){siluf_(a1[0] * f), siluf_(a1[1] * f), siluf_(a1[2] * f), siluf_(a1[3] * f)}; }
                else { v0 = (f32x4){sigmoidf_(a0[0] * f), sigmoidf_(a0[1] * f), sigmoidf_(a0[2] * f), sigmoidf_(a0[3] * f)}; v1 = (f32x4){sigmoidf_(a1[0] * f), sigmoidf_(a1[1] * f), sigmoidf_(a1[2] * f), sigmoidf_(a1[3] * f)}; }
                *(GAS u32x4*)(rowp + bj * 256) = pack8(v0, v1); } }
}
__device__ __forceinline__ void mid_scale(Acc& acc, const GU& u, int wr, int wc) {
    const int ln = lane_now(), r0 = wr * 64 + (ln & 15), c0 = wc * 32 + 8 * (ln >> 4);
#pragma unroll
    for (int ai = 0; ai < 2; ++ai)
#pragma unroll
        for (int mp = 0; mp < 2; ++mp) { EPI_FENCE(); u32x4 wa[2][2], wg[2][2];
#pragma unroll
            for (int mm = 0; mm < 2; ++mm) { const size_t ro = (size_t)(r0 + ai * 128 + (2 * mp + mm) * 16) * u.ldx + (size_t)c0 * 2;
#pragma unroll
                for (int bj = 0; bj < 2; ++bj) { wa[mm][bj] = *(const GAS u32x4*)(u.x0 + ro + bj * 256); wg[mm][bj] = *(const GAS u32x4*)(u.x1 + ro + bj * 256); } }
#pragma unroll
            for (int mm = 0; mm < 2; ++mm)
#pragma unroll
                for (int bj = 0; bj < 2; ++bj) { const int m = 2 * mp + mm; f32x4 a0, a1, g0, g1; unpack8(wa[mm][bj], a0, a1); unpack8(wg[mm][bj], g0, g1);
#pragma unroll
                    for (int t = 0; t < 4; ++t) { acc[ai][bj][m][0][t] *= a0[t] * frcp(g0[t]); acc[ai][bj][m][1][t] *= a1[t] * frcp(g1[t]); } } }
}
#define KM(k) (KIND == (k))
template <int KIND>
__device__ __forceinline__ void epilogue(Acc& acc, const GU& u, int wr, int wc) {
    const int ln = lane_now(), r0 = wr * 64 + (ln & 15), c0 = wc * 32 + 8 * (ln >> 4);
    switch (KIND) {
    case K_SCALE: if constexpr (KM(K_SCALE)) { epi_bf16<0>(acc, u, r0, c0); } break;
    case K_SILU: if constexpr (KM(K_SILU)) { epi_bf16<1>(acc, u, r0, c0); } break;
    case K_SIG: if constexpr (KM(K_SIG)) { epi_bf16<2>(acc, u, r0, c0); } break;
    case K_ROT: if constexpr (KM(K_ROT)) {
        const float f = __int_as_float(u.i1);
        float invf[8];
#pragma unroll
        for (int j = 0; j < 8; ++j) invf[j] = INVF[c0 + j];
#pragma unroll
        for (int ai = 0; ai < 2; ++ai)
#pragma unroll
            for (int m = 0; m < 4; ++m) { EPI_FENCE(); const int row = r0 + ai * 128 + m * 16; const float pos = (float)((u.i0 + row) & (SEQ - 1));
                char* rowp = u.out + (size_t)row * u.ldo + (size_t)c0 * 2; f32x4 o1[2], o2[2];
#pragma unroll
                for (int n = 0; n < 2; ++n)
#pragma unroll
                    for (int t = 0; t < 4; ++t) { float s, c; sincos_pos(pos * invf[4 * n + t], s, c); const float t1 = acc[ai][0][m][n][t], t2 = acc[ai][1][m][n][t];
                        o1[n][t] = (t1 * c - t2 * s) * f; o2[n][t] = (t1 * s + t2 * c) * f; }
                *(GAS u32x4*)(rowp) = pack8(o1[0], o1[1]); *(GAS u32x4*)(rowp + 256) = pack8(o2[0], o2[1]); }
    } break;
    case K_ROTT: if constexpr (KM(K_ROTT)) {
        const float lg = LOG2G[u.i1]; float dec[8];
#pragma unroll
        for (int j = 0; j < 8; ++j) dec[j] = 0.0625f * fexp2((float)(127 - (c0 + j)) * lg);
#pragma unroll
        for (int m = 0; m < 4; ++m) { const int row = r0 + m * 16; const float iv = INVF[row];
#pragma unroll
            for (int bj = 0; bj < 2; ++bj) { EPI_FENCE(); f32x4 o1[2], o2[2];
#pragma unroll
                for (int n = 0; n < 2; ++n)
#pragma unroll
                    for (int t = 0; t < 4; ++t) { const float pos = (float)((u.i0 + bj * 128 + c0 + 4 * n + t) & (SEQ - 1)); float s, c; sincos_pos(pos * iv, s, c);
                        const float t1 = acc[0][bj][m][n][t], t2 = acc[1][bj][m][n][t], d = dec[4 * n + t];
                        o1[n][t] = (t1 * c - t2 * s) * d; o2[n][t] = (t1 * s + t2 * c) * d; }
                char* p1 = u.out + (size_t)row * u.ldo + (size_t)(bj * 128 + c0) * 2;
                *(GAS u32x4*)(p1) = pack8(o1[0], o1[1]); *(GAS u32x4*)(p1 + (size_t)128 * u.ldo) = pack8(o2[0], o2[1]); } }
    } break;
    case K_FIN: if constexpr (KM(K_FIN)) {
#pragma unroll
        for (int ai = 0; ai < 2; ++ai) { EPI_FENCE(); u32x4 wg[4][2];
#pragma unroll
            for (int m = 0; m < 4; ++m) { const size_t ro = (size_t)(r0 + ai * 128 + m * 16) * u.ldx + (size_t)c0 * 2;
#pragma unroll
                for (int bj = 0; bj < 2; ++bj) wg[m][bj] = *(const GAS u32x4*)(u.x1 + ro + bj * 256); }
#pragma unroll
            for (int m = 0; m < 4; ++m) { char* rowp = u.out + (size_t)(r0 + ai * 128 + m * 16) * u.ldo + (size_t)c0 * 2;
#pragma unroll
                for (int bj = 0; bj < 2; ++bj) { f32x4 g0, g1; unpack8(wg[m][bj], g0, g1);
                    *(GAS u32x4*)(rowp + bj * 256) = pack8(acc[ai][bj][m][0] * g0, acc[ai][bj][m][1] * g1); } } }
    } break;
    case K_WO: if constexpr (KM(K_WO)) {
        const float f = __int_as_float(u.i0);
#pragma unroll
        for (int ai = 0; ai < 2; ++ai)
#pragma unroll
            for (int mp = 0; mp < 2; ++mp) { EPI_FENCE(); f32x4 xv[2][2][2];
#pragma unroll
                for (int mm = 0; mm < 2; ++mm) { const size_t xo = (size_t)(r0 + ai * 128 + (2 * mp + mm) * 16) * u.ldx + (size_t)c0 * 4;
#pragma unroll
                    for (int bj = 0; bj < 2; ++bj) { xv[mm][bj][0] = __builtin_nontemporal_load((const GAS f32x4*)(u.x0 + xo + bj * 512)); xv[mm][bj][1] = __builtin_nontemporal_load((const GAS f32x4*)(u.x0 + xo + bj * 512 + 16)); } }
#pragma unroll
                for (int mm = 0; mm < 2; ++mm) { const int m = 2 * mp + mm; char* rowp = u.out + (size_t)(r0 + ai * 128 + m * 16) * u.ldo + (size_t)c0 * 2;
#pragma unroll
                    for (int bj = 0; bj < 2; ++bj) *(GAS u32x4*)(rowp + bj * 256) = pack8(xv[mm][bj][0] * f + acc[ai][bj][m][0], xv[mm][bj][1] * f + acc[ai][bj][m][1]); } }
    } break;
    case K_SWIGLU: if constexpr (KM(K_SWIGLU)) {
#pragma unroll
        for (int ai = 0; ai < 2; ++ai)
#pragma unroll
            for (int m = 0; m < 4; ++m) { EPI_FENCE(); char* rowp = u.out + (size_t)(r0 + ai * 128 + m * 16) * u.ldo + (size_t)c0 * 2; f32x4 h0, h1;
#pragma unroll
                for (int t = 0; t < 4; ++t) { h0[t] = siluf_(acc[ai][0][m][0][t]) * acc[ai][1][m][0][t]; h1[t] = siluf_(acc[ai][0][m][1][t]) * acc[ai][1][m][1][t]; }
                *(GAS u32x4*)(rowp) = pack8(h0, h1); }
    } break;
    case K_PLE: if constexpr (KM(K_PLE)) {
#pragma unroll
        for (int ai = 0; ai < 2; ++ai) { EPI_FENCE(); u32x4 wt[4][2];
#pragma unroll
            for (int m = 0; m < 4; ++m) { const size_t to = (size_t)(r0 + ai * 128 + m * 16) * u.ldx + (size_t)c0 * 2;
#pragma unroll
                for (int bj = 0; bj < 2; ++bj) wt[m][bj] = *(const GAS u32x4*)(u.x0 + to + bj * 256); }
#pragma unroll
            for (int m = 0; m < 4; ++m) { char* rowp = u.out + (size_t)(r0 + ai * 128 + m * 16) * u.ldo + (size_t)c0 * 2;
#pragma unroll
                for (int bj = 0; bj < 2; ++bj) { f32x4 t0, t1; unpack8(wt[m][bj], t0, t1); const f32x4 a0 = acc[ai][bj][m][0], a1 = acc[ai][bj][m][1];
                    const f32x4 o0 = {sigmoidf_(a0[0]) * t0[0], sigmoidf_(a0[1]) * t0[1], sigmoidf_(a0[2]) * t0[2], sigmoidf_(a0[3]) * t0[3]};
                    const f32x4 o1 = {sigmoidf_(a1[0]) * t1[0], sigmoidf_(a1[1]) * t1[1], sigmoidf_(a1[2]) * t1[2], sigmoidf_(a1[3]) * t1[3]};
                    *(GAS u32x4*)(rowp + bj * 256) = pack8(o0, o1); } } }
    } break;
    case K_DOWN: if constexpr (KM(K_DOWN)) {
        const GAS f32x2_t* stat = (const GAS f32x2_t*)u.x0 + u.i0; const GAS f32x4* gb = (const GAS f32x4*)((const GAS f32x2_t*)u.x0 + M + u.i1 + c0);
        f32x4 gbv[2][4];
#pragma unroll
        for (int bj = 0; bj < 2; ++bj)
#pragma unroll
            for (int j = 0; j < 4; ++j) gbv[bj][j] = gb[bj * 64 + j];
#pragma unroll
        for (int ai = 0; ai < 2; ++ai)
#pragma unroll
            for (int mp = 0; mp < 2; ++mp) { EPI_FENCE(); u32x4 xw[2][2]; u32x4 pl[2][2]; f32x2_t st[2];
#pragma unroll
                for (int mm = 0; mm < 2; ++mm) { const int row = r0 + ai * 128 + (2 * mp + mm) * 16; const size_t po = (size_t)row * u.ldx + (size_t)c0 * 2; const char* xp = u.x1 + ((ptrdiff_t)WS_P1B - (ptrdiff_t)WS_T) + po; st[mm] = stat[row];
#pragma unroll
                    for (int bj = 0; bj < 2; ++bj) { xw[mm][bj] = *(const GAS u32x4*)(xp + bj * 256); pl[mm][bj] = *(const GAS u32x4*)(u.x1 + po + bj * 256); } }
#pragma unroll
                for (int mm = 0; mm < 2; ++mm) { const int m = 2 * mp + mm; char* rowp = (char*)u.x1 + ((ptrdiff_t)WS_P2B - (ptrdiff_t)WS_T) + (size_t)(r0 + ai * 128 + m * 16) * u.ldx + (size_t)c0 * 2; const float mu = st[mm][0], rs = st[mm][1];
#pragma unroll
                    for (int bj = 0; bj < 2; ++bj) { f32x4 p0, p1, x0, x1; unpack8(pl[mm][bj], p0, p1); unpack8(xw[mm][bj], x0, x1); const f32x4 a0 = acc[ai][bj][m][0], a1 = acc[ai][bj][m][1];
                        const f32x4 g01 = gbv[bj][0], g23 = gbv[bj][1], g45 = gbv[bj][2], g67 = gbv[bj][3];
                        const f32x4 o0 = {(x0[0] - mu) * rs * g01[0] + g01[1] + p0[0] + a0[0], (x0[1] - mu) * rs * g01[2] + g01[3] + p0[1] + a0[1], (x0[2] - mu) * rs * g23[0] + g23[1] + p0[2] + a0[2], (x0[3] - mu) * rs * g23[2] + g23[3] + p0[3] + a0[3]};
                        const f32x4 o1 = {(x1[0] - mu) * rs * g45[0] + g45[1] + p1[0] + a1[0], (x1[1] - mu) * rs * g45[2] + g45[3] + p1[1] + a1[1], (x1[2] - mu) * rs * g67[0] + g67[1] + p1[2] + a1[2], (x1[3] - mu) * rs * g67[2] + g67[3] + p1[3] + a1[3]};
                        *(GAS u32x4*)(rowp + bj * 256) = pack8(o0, o1); } } }
    } break;
    default: break;
    }
}

#define CAS __attribute__((address_space(4)))
__device__ __forceinline__ bool fetch_unit(const unsigned* tab, int i, int count, GU& u) {
    if (i >= count) return false;
    const CAS unsigned long long* e8 = (const CAS unsigned long long*)(const CAS void*)(tab + (size_t)i * GU_DW);
    const CAS unsigned* e4 = (const CAS unsigned*)e8;
    u.A = (const char*)e8[0]; u.B = (const char*)e8[1]; u.out = (char*)e8[2]; u.x0 = (const char*)e8[3]; u.x1 = (const char*)e8[4];
    u.sA = e4[10]; u.sB = e4[11]; u.nt = (int)e4[12]; u.ldo = e4[13]; u.ldx = e4[14]; u.i0 = (int)e4[15]; u.i1 = (int)e4[16];
    return u.nt != 0;
}
template <int KIND, int CHAIN, bool FP8 = false, bool ALT = false>
__device__ __forceinline__ void gemm_stream(LAS unsigned char* lds, const unsigned* tab, int count, int wid) {
    const int wr = wid >> 2, wc = wid & 3;
    int aoff, boff; { const int lane = lane_now(), fr = lane & 15, fq = lane >> 4; aoff = lds_byte(wr * 64 + fr, fq * 8); boff = lds_byte(wc * 32 + fr, fq * 8); }
#define GE_LANE_RC(rA0, rB0, cc0) unsigned rA0, rB0, cc0; { const int _t = wid * 64 + lane_now(); int R, C; stage_rc(_t * 16, R, C); rA0 = (unsigned)R; rB0 = (unsigned)((R & ~31) + perm32(R & 31)); cc0 = (unsigned)C * 2u; }
    const unsigned ldsw = (unsigned)wid * 1024u;
    const unsigned ldsbase = (unsigned)__builtin_amdgcn_readfirstlane((int)((unsigned)(size_t)lds + ldsw));
#define GE_SA(b, h) (((b) * 2 + (h)) * HTB)
#define GE_SB(b, h) ((4 + (b) * 2 + (h)) * HTB)
#define GE_DMA(sbase, voff, ldsaddr) do { unsigned _keep; asm volatile("s_mov_b32 %0, m0\n\ts_mov_b32 m0, %3\n\ts_nop 0\n\tglobal_load_lds_dwordx4 %1, %2\n\ts_mov_b32 m0, %0" \
        : "=&s"(_keep) : "v"(voff), "s"(sbase), "s"(ldsaddr) : "memory"); } while (0)
#define GE_STAGE(bufoff, gbase, voff, s64) do { const char* _b0 = (const char*)(gbase); const char* _b1 = _b0 + (s64); \
        GE_DMA(_b0, (voff), ldsbase + (unsigned)(bufoff)); GE_DMA(_b1, (voff), ldsbase + (unsigned)(bufoff) + 8192u); } while (0)
#define GE_LDA(dst, b, h) do { _Pragma("unroll") for (int m = 0; m < 4; ++m) _Pragma("unroll") for (int k = 0; k < 2; ++k) dst[m][k] = *(const LAS bf16x8*)(lds + GE_SA(b, h) + aoff + m * 2048 + k * 1024); } while (0)
#define GE_LDB(dst, b, h) do { _Pragma("unroll") for (int n = 0; n < 2; ++n) _Pragma("unroll") for (int k = 0; k < 2; ++k) dst[n][k] = *(const LAS bf16x8*)(lds + GE_SB(b, h) + boff + n * 2048 + k * 1024); } while (0)
#define GE_MMA(ai, bj, At, Bt) do { __builtin_amdgcn_s_setprio(1); \
        if (FP8) { typedef int i4_t __attribute__((ext_vector_type(4))); typedef int i8_t __attribute__((ext_vector_type(8))); \
            _Pragma("unroll") for (int m = 0; m < 4; ++m) _Pragma("unroll") for (int n = 0; n < 2; ++n) { \
                const i8_t a8 = __builtin_shufflevector(__builtin_bit_cast(i4_t, At[m][0]), __builtin_bit_cast(i4_t, At[m][1]), 0, 1, 2, 3, 4, 5, 6, 7); \
                const i8_t b8 = __builtin_shufflevector(__builtin_bit_cast(i4_t, Bt[n][0]), __builtin_bit_cast(i4_t, Bt[n][1]), 0, 1, 2, 3, 4, 5, 6, 7); \
                acc[ai][bj][m][n] = __builtin_amdgcn_mfma_scale_f32_16x16x128_f8f6f4(b8, a8, acc[ai][bj][m][n], 0, 0, 0, 0x7F7F7F7F, 0, 0x79797979); \
                asm volatile("" : "+v"(acc[ai][bj][m][n])); } } \
        else { _Pragma("unroll") for (int m = 0; m < 4; ++m) _Pragma("unroll") for (int n = 0; n < 2; ++n) _Pragma("unroll") for (int k = 0; k < 2; ++k) \
            acc[ai][bj][m][n] = __builtin_amdgcn_mfma_f32_16x16x32_bf16(Bt[n][k], At[m][k], acc[ai][bj][m][n], 0, 0, 0); } \
        __builtin_amdgcn_s_setprio(0); } while (0)
#define GE_WAIT_V(n) asm volatile("s_waitcnt vmcnt(" #n ")" ::: "memory")
#define GE_WAIT_L(n) asm volatile("s_waitcnt lgkmcnt(" #n ")" ::: "memory")
#define GE_BAR __builtin_amdgcn_s_barrier()
#define GE_SCHED __builtin_amdgcn_sched_barrier(0)
#define GE_ZERO() do { _Pragma("unroll") for (int a = 0; a < 2; ++a) _Pragma("unroll") for (int b = 0; b < 2; ++b) _Pragma("unroll") for (int m = 0; m < 4; ++m) _Pragma("unroll") for (int n = 0; n < 2; ++n) acc[a][b][m][n] = (f32x4){0.f, 0.f, 0.f, 0.f}; } while (0)
#define GE_BODY(a1, a2, b2, a3, b3, v2A, v2B, h2A, h2B, q2A, q2B) do { \
            GE_LDB(B0, 0, 0); GE_LDB(B1, 0, 1); GE_SCHED; GE_LDA(At, 0, 0); GE_STAGE(GE_SA(1, 1), (a1) + chA, cvA, cqA); \
            GE_WAIT_V(8); GE_WAIT_L(0); GE_BAR; GE_MMA(0, 0, At, B0); GE_MMA(0, 1, At, B1); GE_BAR; GE_SCHED; \
            GE_LDA(At, 0, 1); GE_STAGE(GE_SB(0, 0), (b2), v2B, q2B); GE_STAGE(GE_SB(0, 1), (b2) + (h2B), v2B, q2B); GE_STAGE(GE_SA(0, 0), (a2), v2A, q2A); \
            GE_WAIT_V(8); GE_WAIT_L(0); GE_BAR; GE_MMA(1, 0, At, B0); GE_MMA(1, 1, At, B1); GE_BAR; GE_SCHED; \
            GE_LDB(B0, 1, 0); GE_LDB(B1, 1, 1); GE_SCHED; GE_LDA(At, 1, 0); GE_STAGE(GE_SA(0, 1), (a2) + (h2A), v2A, q2A); \
            GE_WAIT_V(8); GE_WAIT_L(0); GE_BAR; GE_MMA(0, 0, At, B0); GE_MMA(0, 1, At, B1); GE_BAR; GE_SCHED; \
            GE_LDA(At, 1, 1); GE_STAGE(GE_SB(1, 0), (b3), v2B, q2B); GE_STAGE(GE_SB(1, 1), (b3) + (h2B), v2B, q2B); GE_STAGE(GE_SA(1, 0), (a3), v2A, q2A); \
            GE_WAIT_V(8); GE_WAIT_L(0); GE_BAR; GE_MMA(1, 0, At, B0); GE_MMA(1, 1, At, B1); GE_BAR; GE_SCHED; } while (0)
    GU cur, nxt; int ui = 0;
    if (!fetch_unit(tab, 0, count, cur)) return;
    Acc acc; GE_ZERO();
    bf16x8 At[4][2], B0[2][2], B1[2][2];
    unsigned cvA, cvB; { GE_LANE_RC(rA0, rB0, cc0); cvA = rA0 * cur.sA + cc0; cvB = rB0 * cur.sB + cc0; }
    const char* cA = cur.A; const char* cB = cur.B; size_t chA = (size_t)128 * cur.sA, chB = (size_t)128 * cur.sB, cqA = (size_t)64 * cur.sA, cqB = (size_t)64 * cur.sB;
    ptrdiff_t kstep = ALT ? -128 : 128;
    GE_STAGE(GE_SB(0, 0), cB, cvB, cqB); GE_STAGE(GE_SB(0, 1), cB + chB, cvB, cqB); GE_STAGE(GE_SA(0, 0), cA, cvA, cqA); GE_STAGE(GE_SA(0, 1), cA + chA, cvA, cqA);
    if (wr == 1) GE_BAR;
    GE_WAIT_V(2); GE_BAR;
    GE_STAGE(GE_SB(1, 0), cB + kstep, cvB, cqB); GE_STAGE(GE_SA(1, 0), cA + kstep, cvA, cqA); GE_STAGE(GE_SB(1, 1), cB + chB + kstep, cvB, cqB);
    GE_WAIT_V(6); GE_BAR;
    for (;;) {
        const bool has_next = fetch_unit(tab, ui + 1, count, nxt);
        const int nt = cur.nt;
        for (int t = 0; t < nt - 2; t += 2) {
            const char* a1 = cA + (ptrdiff_t)(t + 1) * kstep; const char* a2 = cA + (ptrdiff_t)(t + 2) * kstep; const char* b2 = cB + (ptrdiff_t)(t + 2) * kstep;
            GE_BODY(a1, a2, b2, a2 + kstep, b2 + kstep, cvA, cvB, chA, chB, cqA, cqB);
        }
        {
            const char* nA = cA; const char* nB = cB; size_t nhA = chA, nhB = chB, nqA = cqA, nqB = cqB; unsigned nvA = cvA, nvB = cvB;
            if (has_next) { nA = nxt.A; nB = nxt.B; nhA = (size_t)128 * nxt.sA; nhB = (size_t)128 * nxt.sB; nqA = (size_t)64 * nxt.sA; nqB = (size_t)64 * nxt.sB; GE_LANE_RC(rA0, rB0, cc0); nvA = rA0 * nxt.sA + cc0; nvB = rB0 * nxt.sB + cc0; }
            const char* a1 = cA + (ptrdiff_t)(nt - 1) * kstep; const ptrdiff_t nks = ALT ? (has_next ? -kstep : kstep) : 128;
            GE_BODY(a1, nA, nB, nA + nks, nB + nks, nvA, nvB, nhA, nhB, nqA, nqB);
            if (wr == 0) GE_BAR;
            if (CHAIN == 1 && !(ui & 1)) { mid_scale(acc, cur, wr, wc); }
            else if (CHAIN == 2) { epilogue<KIND>(acc, cur, wr, wc); const float f = __int_as_float(cur.i1);
                _Pragma("unroll") for (int a = 0; a < 2; ++a) _Pragma("unroll") for (int b = 0; b < 2; ++b) _Pragma("unroll") for (int m = 0; m < 4; ++m) _Pragma("unroll") for (int n = 0; n < 2; ++n) { acc[a][b][m][n] = acc[a][b][m][n] * f; asm volatile("" : "+v"(acc[a][b][m][n])); } }
            else { epilogue<KIND>(acc, cur, wr, wc); if (has_next) GE_ZERO(); }
            if (!has_next) break;
            cur = nxt; cA = nA; cB = nB; chA = nhA; chB = nhB; cqA = nqA; cqB = nqB; cvA = nvA; cvB = nvB; if (ALT) kstep = -kstep;
            ++ui;
            if (wr == 1) GE_BAR;
        }
    }
    GE_WAIT_V(0);
    GE_BAR;
#undef GE_BODY
#undef GE_LANE_RC
#undef GE_SA
#undef GE_SB
#undef GE_STAGE
#undef GE_LDA
#undef GE_LDB
#undef GE_MMA
#undef GE_WAIT_V
#undef GE_WAIT_L
#undef GE_BAR
#undef GE_SCHED
#undef GE_ZERO
}
}

struct Args { const float* in[16]; float* out; unsigned char* ws; int ph_lo, ph_hi; };
struct Frame {
    LAS unsigned char* lds;
    gu32* ctl;
    int wave, G, c;
    unsigned char* ws;
};

__device__ __forceinline__ int perm_tile_token0(int g, int tile) {
    const int sh = 2 * g, L = SEQ >> sh, m0 = tile * 256, b = m0 >> 12, rem = m0 & (SEQ - 1), r = rem / L, j0 = rem % L;
    return (b << 12) + (j0 << sh) + r;
}

constexpr int SL_P1 = 0, SL_P1B = 13, SL_P1C = 17, SL_P1D = 19, SL_P1E = 23, SL_P3 = 31, SL_P3B = 35, SL_P4 = 43, SL_P5 = 47, SL_P5B = 69, SL_P6 = 74, SL_SCAN = 78, SL_G2 = 109, GX = 3, NSLOT = 109 + 2 * GX;
__device__ __forceinline__ void make_unit(int slot, int c, unsigned char* ws, const float* x, float* outp, ge::GU& u) {
    const char* xb = (const char*)(ws + WS_XB); const char* win = (const char*)(ws + WS_WIN);
    const unsigned rowK = D * 2;
    u.A = nullptr; u.B = nullptr; u.out = nullptr; u.x0 = nullptr; u.x1 = nullptr; u.sA = rowK; u.sB = rowK; u.nt = D / 64; u.ldo = 0; u.ldx = 0; u.i0 = __float_as_int(1.0f); u.i1 = 0; u.pad[0] = u.pad[1] = u.pad[2] = 0;
    if (slot >= SL_G2) {
        const int idx = c >> 3;
        if (c < 64 || (idx % 3) == 2) { u.nt = 0; return; }
        const int k = (idx - 8) - ((idx - 8) / 3 + 1), j = slot - SL_G2;
        c = ((2 * k + j / GX) << 3) | (c & 7); slot = SL_P1E + (8 - GX) + j % GX;
    }
    int pm, pn;
    const char* x8 = (const char*)(ws + WS_X8); const unsigned row8 = D;
    if (slot < 6) {
        const int isK = slot >= 3, g = isK ? slot - 3 : slot; ge::tile_of(c, 64, 4, pm, pn);
        u.A = x8 + (size_t)perm_tile_token0(g, pm) * row8; u.sA = row8 << (2 * g);
        u.B = win + (size_t)((isK ? 3072 : 0) + g * 1024 + pn * 256) * rowK; u.nt = D / 128;
        u.i0 = __float_as_int(isK ? 1.0f : QSCALE);
        u.out = (char*)ws + (isK ? WS_KA : WS_QA) + (size_t)g * ((size_t)M * 1024 * 2) + ((size_t)pm * 256 * 1024 + pn * 256) * 2; u.ldo = 1024 * 2;
    } else if (slot < 9) {
        const int g = slot - 6; ge::tile_of(c, 4, 64, pm, pn);
        u.A = win + (size_t)(6144 + g * 1024 + pm * 256) * rowK;
        u.B = x8 + (size_t)perm_tile_token0(g, pn) * row8; u.sB = row8 << (2 * g); u.nt = D / 128;
        u.out = (char*)ws + WS_VTG + (size_t)g * ((size_t)1024 * M * 2) + ((size_t)pm * 256 * M + pn * 256) * 2; u.ldo = M * 2;
    } else if (slot < 13) {
        ge::tile_of((slot - 9) * 256 + c, 16, 64, pm, pn);
        u.A = win + (size_t)(13312 + pm * 256) * rowK; u.B = xb + (size_t)pn * 256 * rowK;
        u.out = (char*)ws + WS_VTR + ((size_t)pm * 256 * M + pn * 256) * 2; u.ldo = M * 2;
    } else if (slot < 17) {
        const int isK = slot >= 15; ge::tile_of((slot - (isK ? 15 : 13)) * 256 + c, 64, 8, pm, pn);
        u.A = xb + (size_t)pm * 256 * rowK; u.B = win + (size_t)((isK ? 11264 : 9216) + pn * 256) * rowK;
        u.i0 = (pm * 256) & (SEQ - 1); u.i1 = __float_as_int(isK ? 0.0625f : 1.0f);
        u.out = (char*)ws + (isK ? WS_KR : WS_QR) + ((size_t)pm * 256 * 2048 + pn * 256) * 2; u.ldo = 2048 * 2;
    } else if (slot < 19) {
        ge::tile_of((slot - 17) * 256 + c, 8, 64, pm, pn);
        u.A = win + (size_t)(11264 + pm * 256) * rowK; u.B = xb + (size_t)pn * 256 * rowK;
        u.i0 = (pn * 256) & (SEQ - 1); u.i1 = pm;
        u.out = (char*)ws + WS_KPT + ((size_t)pm * 256 * M + pn * 256) * 2; u.ldo = M * 2;
    } else if (slot < 31) {
        const int sgm = (slot - 19) >> 2; ge::tile_of(((slot - 19) & 3) * 256 + c, 64, 16, pm, pn);
        u.A = xb + (size_t)pm * 256 * rowK; u.B = win + (size_t)(17408 + sgm * 4096 + pn * 256) * rowK;
        if (sgm != 0) { u.A = x8 + (size_t)pm * 256 * row8; u.sA = row8; u.nt = D / 128; u.B = (const char*)ws + WS_WG8 + (size_t)((sgm - 1) * 4096 + pn * 256) * row8; u.sB = row8; }
        u.out = (char*)ws + (sgm == 0 ? WS_GR : (sgm == 1 ? WS_GA : WS_GRT)) + ((size_t)pm * 256 * D + pn * 256) * 2; u.ldo = D * 2;
    } else if (slot < 35) {
        ge::tile_of((slot - 31) * 256 + c, 64, 16, pm, pn);
        u.A = (const char*)ws + WS_PB + (size_t)pm * 256 * PLE * 2; u.sA = PLE * 2; u.B = (const char*)ws + WS_WPU + (size_t)pn * 256 * PLE * 2; u.sB = PLE * 2; u.nt = PLE / 64;
        u.out = (char*)ws + WS_T + ((size_t)pm * 256 * D + pn * 256) * 2; u.ldo = D * 2;
    } else if (slot < 43) {
        const int j = slot - 35, part = j & 1; ge::tile_of((j >> 1) * 256 + c, 64, 16, pm, pn);
        const size_t go = ((size_t)pm * 256 * D + pn * 256) * 2;
        u.x0 = (const char*)ws + WS_GA + go; u.x1 = (const char*)ws + WS_GRT + go; u.ldx = D * 2; u.out = (char*)ws + WS_MIX + go; u.ldo = D * 2;
        if (part == 0) { u.A = (const char*)ws + WS_OATT + (size_t)pm * 256 * 1024 * 2; u.sA = 1024 * 2; u.B = (const char*)ws + WS_WAO + (size_t)pn * 256 * 1024 * 2; u.sB = 1024 * 2; u.nt = 1024 / 64; }
        else           { u.A = (const char*)ws + WS_RG + (size_t)pm * 256 * D * 2; u.B = (const char*)ws + WS_WRO + (size_t)pn * 256 * D * 2; }
    } else if (slot < 47) {
        ge::tile_of((slot - 43) * 256 + c, 64, 16, pm, pn);
        u.A = (const char*)ws + WS_MIX + (size_t)pm * 256 * D * 2; u.B = (const char*)ws + WS_WO + (size_t)pn * 256 * D * 2;
        u.i0 = __float_as_int(ALPHA); const size_t fo = ((size_t)pm * 256 * D + pn * 256) * 4;
        u.x0 = (const char*)x + fo; u.ldx = D * 4; u.out = (char*)ws + WS_P1B + fo / 2; u.ldo = D * 2;
    } else if (slot < 69) {
        const int L = (slot - 47) * 256 + c;
        if (L >= 64 * 86) { u.nt = 0; return; }
        ge::tile_of(L, 64, 86, pm, pn);
        u.A = (const char*)ws + WS_H1B + (size_t)pm * 256 * D * 2; u.B = (const char*)ws + WS_WGU + (size_t)pn * 256 * D * 2;
        u.out = (char*)ws + WS_HID + ((size_t)pm * 256 * FF + pn * 128) * 2; u.ldo = FF * 2;
    } else if (slot < 74) {
        const int j = slot - 69;
        if (j >= 3 && c < 128) { u.nt = 0; return; }
        ge::tile_of(j < 3 ? j * 256 + c : 768 + (j - 3) * 128 + (c - 128), 64, 16, pm, pn);
        u.A = x8 + (size_t)pm * 256 * row8; u.sA = row8; u.nt = D / 128; u.B = (const char*)ws + WS_WPG + (size_t)pn * 256 * D * 2;
        u.x0 = (const char*)ws + WS_T + ((size_t)pm * 256 * D + pn * 256) * 2; u.ldx = D * 2;
        u.out = (char*)ws + WS_T + ((size_t)pm * 256 * D + pn * 256) * 2; u.ldo = D * 2;
    } else if (slot < 78) {
        ge::tile_of((slot - 74) * 256 + c, 64, 16, pm, pn);
        u.A = (const char*)ws + WS_HID + (size_t)pm * 256 * FF * 2; u.sA = FF * 2; u.B = (const char*)ws + WS_WD + (size_t)pn * 256 * FF * 2; u.sB = FF * 2; u.nt = FF / 64;
        if (!((slot - 74) & 1)) { u.A += (size_t)(FF / 64 - 1) * 128; u.B += (size_t)(FF / 64 - 1) * 128; }
        u.i0 = pm * 256; u.i1 = pn * 256; const size_t fo = ((size_t)pm * 256 * D + pn * 256) * 4;
        u.x0 = (const char*)ws + WS_STAT; u.x1 = (const char*)ws + WS_T + fo / 2; u.ldx = D * 2;
    } else {
        if (c >= 64) { u.nt = 0; return; }
        const int n = slot - 78, b = c >> 4, h = (c >> 1) & 7, eh = c & 1;
        u.A = (const char*)ws + WS_VTR + ((size_t)(h * 512 + eh * 256) * M + b * SEQ + n * 128) * 2; u.sA = M * 2;
        u.B = (const char*)ws + WS_KPT + ((size_t)(h * 256) * M + b * SEQ + n * 128) * 2; u.sB = M * 2; u.nt = 2;
        u.out = (char*)ws + WS_ST + ((size_t)((b * 8 + h) * 32 + n + 1) * 512 + eh * 256) * 256 * 2; u.ldo = 256 * 2;
        u.i0 = __float_as_int(1.0f); u.i1 = __float_as_int(exp2f(128.0f * LOG2G[h]));
    }
}

__device__ __forceinline__ void p0_transpose_item(const float* W, int K, int N, bf16* WT, int mode, LAS float* scr, int item, int lane) {
    const int nblk = N / 32, kb = item / nblk, nb = item % nblk, k0 = 64 * kb, n0 = 32 * nb;
    { f32x4 v[8]; const int c4 = 4 * (lane & 7);
#pragma unroll
      for (int i = 0; i < 8; ++i) v[i] = __builtin_nontemporal_load((const GAS f32x4*)(W + (size_t)(k0 + 8 * i + (lane >> 3)) * N + n0 + c4));
#pragma unroll
      for (int i = 0; i < 8; ++i) { LAS float* d = scr + (8 * i + (lane >> 3)) * 33 + c4; d[0] = v[i][0]; d[1] = v[i][1]; d[2] = v[i][2]; d[3] = v[i][3]; } }
    LDS_WAIT(); asm volatile("" ::: "memory");
    const int c = lane & 7;
    const int nbase = (mode == 0 || mode >= 3) ? n0 : ((n0 >> 7) * 256 + (n0 & 127) + (mode == 2 ? 128 : 0));
#pragma unroll
    for (int j = 0; j < 4; ++j) { const int n = (lane >> 3) + 8 * j; const LAS float* s = scr + (8 * c) * 33 + n;
        if (mode >= 3) { u32x2 o8; o8.x = pk_fp8x4(64.f * s[0 * 33], 64.f * s[1 * 33], 64.f * s[2 * 33], 64.f * s[3 * 33]); o8.y = pk_fp8x4(64.f * s[4 * 33], 64.f * s[5 * 33], 64.f * s[6 * 33], 64.f * s[7 * 33]);
            __builtin_nontemporal_store(o8, (GAS u32x2*)((char*)WT + (size_t)(nbase + n) * (mode == 3 ? K * 2 : K) + k0 + 8 * c)); continue; }
        u32x4 o; o.x = cvtpk(s[0 * 33], s[1 * 33]); o.y = cvtpk(s[2 * 33], s[3 * 33]); o.z = cvtpk(s[4 * 33], s[5 * 33]); o.w = cvtpk(s[6 * 33], s[7 * 33]);
        __builtin_nontemporal_store(o, (GAS u32x4*)(WT + (size_t)(nbase + n) * K + k0 + 8 * c)); }
    LDS_WAIT(); asm volatile("" ::: "memory");
}
constexpr int I_IN = (D / 64) * (NIN / 32), I_AO = (1024 / 64) * (D / 32), I_SQ = (D / 64) * (D / 32), I_FF = (D / 64) * (FF / 32), I_DN = (FF / 64) * (D / 32), I_PU = (PLE / 64) * (D / 32);
constexpr int N_LATE = I_AO + 3 * I_SQ + 2 * I_FF + I_DN + I_PU;
__device__ __forceinline__ void late_weight_item(const Args& a, unsigned char* ws, LAS float* scr, int r, int lane) {
    if (r < I_AO) { p0_transpose_item(a.in[3], 1024, D, (bf16*)(ws + WS_WAO), 0, scr, r, lane); return; } r -= I_AO;
    if (r < I_SQ) { p0_transpose_item(a.in[4], D, D, (bf16*)(ws + WS_WRO), 0, scr, r, lane); return; } r -= I_SQ;
    if (r < I_SQ) { p0_transpose_item(a.in[6], D, D, (bf16*)(ws + WS_WO), 0, scr, r, lane); return; } r -= I_SQ;
    if (r < I_FF) { p0_transpose_item(a.in[9], D, FF, (bf16*)(ws + WS_WGU), 1, scr, r, lane); return; } r -= I_FF;
    if (r < I_FF) { p0_transpose_item(a.in[10], D, FF, (bf16*)(ws + WS_WGU), 2, scr, r, lane); return; } r -= I_FF;
    if (r < I_DN) { p0_transpose_item(a.in[11], FF, D, (bf16*)(ws + WS_WD), 0, scr, r, lane); return; } r -= I_DN;
    if (r < I_SQ) { p0_transpose_item(a.in[12], D, D, (bf16*)(ws + WS_WPG), 3, scr, r, lane); return; } r -= I_SQ;
    p0_transpose_item(a.in[13], PLE, D, (bf16*)(ws + WS_WPU), 0, scr, r, lane);
}
__device__ __forceinline__ void late_weights_queue(Frame& F, const Args& a, int cw) {
    LAS float* scr = (LAS float*)(F.lds + F.wave * 16384);
    unsigned cur = 0u, end = 0u;
    for (;;) {
        const int lane = lane_now();
        if (cur == end) { unsigned idx = 0;
            if (lane == 0) idx = __hip_atomic_fetch_add((unsigned*)(F.ctl + cw), 64u, RLX_AGENT);
            idx = (unsigned)__builtin_amdgcn_readfirstlane((int)idx);
            if (idx >= (unsigned)N_LATE) break;
            cur = idx; end = idx + 64u < (unsigned)N_LATE ? idx + 64u : (unsigned)N_LATE; }
        late_weight_item(a, F.ws, scr, (int)cur, lane); ++cur;
    }
}
__device__ __forceinline__ void p0_prologue(Frame& F, const Args& a) {
    const int lane = lane_now(), tid = F.wave * 64 + lane;
    if (tid < NSLOT) { ge::GU u; make_unit(tid, F.c, F.ws, a.in[0], a.out, u);
        GAS unsigned* dst = (GAS unsigned*)(F.ws + WS_TAB) + ((size_t)F.c * NSLOT + tid) * ge::GU_DW; const unsigned* src = (const unsigned*)&u;
#pragma unroll
        for (int k = 0; k < ge::GU_DW; ++k) dst[k] = src[k]; }
    LAS float* scr = (LAS float*)(F.lds + F.wave * 16384);
    const int gw = F.c * NWAVES + F.wave, NGW = F.G * NWAVES;
    unsigned char* ws = F.ws;
    for (int it = gw; it < I_IN; it += NGW) { const int n0 = 32 * (it % (NIN / 32));
        if (n0 >= 21504) p0_transpose_item(a.in[2], D, NIN, (bf16*)(ws + WS_WG8 - (size_t)21504 * D), 4, scr, it, lane);
        else p0_transpose_item(a.in[2], D, NIN, (bf16*)(ws + WS_WIN), n0 < 9216 ? 3 : 0, scr, it, lane); }
    const size_t gt = (size_t)F.c * 512 + tid, NT = (size_t)F.G * 512;
    { const GAS f32x4* src = (const GAS f32x4*)a.in[0]; GAS u32x4* dst = (GAS u32x4*)(ws + WS_XB);
      GAS u32x2* dst8 = (GAS u32x2*)(ws + WS_X8);
      for (size_t i = gt; i < (size_t)M * D / 8; i += NT) { const f32x4 v0 = __builtin_nontemporal_load(src + 2 * i), v1 = __builtin_nontemporal_load(src + 2 * i + 1); dst[i] = ge::pack8(v0, v1);
          u32x2 w8; w8.x = pk_fp8x4(v0[0], v0[1], v0[2], v0[3]); w8.y = pk_fp8x4(v1[0], v1[1], v1[2], v1[3]); dst8[i] = w8; } }
    { const GAS f32x4* src = (const GAS f32x4*)a.in[1]; GAS u32x4* dst = (GAS u32x4*)(ws + WS_PB);
      for (size_t i = gt; i < (size_t)M * PLE / 8; i += NT) { const f32x4 v0 = src[2 * i], v1 = src[2 * i + 1]; dst[i] = ge::pack8(v0, v1); } }
}

#define MFMA32(a, b, c) __builtin_amdgcn_mfma_f32_32x32x16_bf16((a), (b), (c), 0, 0, 0)
__device__ __forceinline__ bf16x8 ldg8(const bf16* p) { return *(const GAS bf16x8*)p; }
__device__ __forceinline__ bf16x8 pack_frag(const f32x16& x, int s) {
    u32x4 p; p.x = cvtpk(x[8 * s + 0], x[8 * s + 1]); p.y = cvtpk(x[8 * s + 2], x[8 * s + 3]); p.z = cvtpk(x[8 * s + 4], x[8 * s + 5]); p.w = cvtpk(x[8 * s + 6], x[8 * s + 7]);
    return __builtin_bit_cast(bf16x8, p);
}
__device__ __forceinline__ f32x16 zero16() { f32x16 z;
#pragma unroll
    for (int i = 0; i < 16; ++i) z[i] = 0.f; return z; }

__device__ __forceinline__ void attn_wg_item(int item, unsigned char* ws, LAS unsigned char* lds, int w, int lane) {
    const int g = item >> 9, rem = item & 511, head = rem >> 6, qb = rem & 63;
    const int L = SEQ >> (2 * g), prow0 = qb * 256, q0 = prow0 & (L - 1), r32 = lane & 31, hh = lane >> 5;
    const bf16* Q = (const bf16*)(ws + WS_QA) + (size_t)g * M * 1024 + head * 128 + 8 * hh;
    const bf16* Kg = (const bf16*)(ws + WS_KA) + (size_t)g * M * 1024 + head * 128;
    const bf16* VTg = (const bf16*)(ws + WS_VTG) + (size_t)g * 1024 * M + (size_t)(head * 128) * M;
#define AW_ISSUE(p) do { LAS unsigned char* bufp_ = lds + ((p) & 1) * 65536; const int krow_ = prow0 - 128 + 128 * (p); _Pragma("unroll") for (int i_ = 0; i_ < 4; ++i_) { \
        const int row_ = 4 * (4 * w + i_) + (lane >> 4), pc_ = (lane & 15) ^ (row_ & 15); \
        __builtin_amdgcn_global_load_lds((const unsigned*)(Kg + (size_t)(krow_ + row_) * 1024 + pc_ * 8), (LAS unsigned*)(bufp_ + (4 * w + i_) * 1024), 16, 0, 0); \
        __builtin_amdgcn_global_load_lds((const unsigned*)(VTg + (size_t)row_ * M + krow_ + pc_ * 8), (LAS unsigned*)(bufp_ + 32768 + (4 * w + i_) * 1024), 16, 0, 0); } } while (0)
    const int p0 = q0 >= 128 ? 0 : 1;
    bf16x8 qf[8];
#pragma unroll
    for (int kb = 0; kb < 8; ++kb) qf[kb] = ldg8(Q + (size_t)(prow0 + 32 * w + r32) * 1024 + kb * 16);
    AW_ISSUE(p0);
    f32x16 o[4]; o[0] = zero16(); o[1] = zero16(); o[2] = zero16(); o[3] = zero16();
    float mrun = -1e30f, lrun = 0.f;
    const int kperm = (r32 & ~12) | ((r32 & 4) << 1) | ((r32 & 8) >> 1);
    for (int p = p0; p < 3; ++p) {
        VM_WAIT(); __syncthreads();
        if (p < 2) AW_ISSUE(p + 1);
        asm volatile("" ::: "memory"); __builtin_amdgcn_sched_barrier(0);
        const LAS unsigned char* kb_ = lds + (p & 1) * 65536; const LAS unsigned char* vb_ = kb_ + 32768;
        const int ch_lo = 4 * p > w ? 4 * p : w, ch_hi = 4 * p + 4 < w + 5 ? 4 * p + 4 : w + 5;
        for (int ch = ch_lo; ch < ch_hi; ++ch) {
            const int c = ch - w, cl = ch - 4 * p;
            if (q0 + 32 * w - 128 + 32 * c < 0) continue;
            bf16x8 kf[8];
            { const int krow = cl * 32 + kperm; const LAS unsigned char* kr = kb_ + krow * 256; const int kx = krow & 15;
#pragma unroll
              for (int kb = 0; kb < 8; ++kb) kf[kb] = *(const LAS bf16x8*)(kr + (((2 * kb + hh) ^ kx) << 4)); }
            f32x16 sa = zero16();
#pragma unroll
            for (int kb = 0; kb < 8; ++kb) sa = MFMA32(kf[kb], qf[kb], sa);
            float cm = -1e30f;
#pragma unroll
            for (int i = 0; i < 16; ++i) { const int kap = (i & 7) + 8 * hh + 16 * (i >> 3);
                const bool valid = !((c == 0 && kap < r32) || (c == 4 && kap > r32));
                sa[i] = valid ? sa[i] : -1e30f; cm = fmaxf(cm, sa[i]); }
            cm = fmaxf(cm, __shfl_xor(cm, 32));
            const float mnew = fmaxf(mrun, cm), alpha = fexp2(mrun - mnew);
            float ps = 0.f;
#pragma unroll
            for (int i = 0; i < 16; ++i) { sa[i] = fexp2(sa[i] - mnew); ps += sa[i]; }
            ps += __shfl_xor(ps, 32);
            lrun = lrun * alpha + ps; mrun = mnew;
            const bf16x8 pf0 = pack_frag(sa, 0), pf1 = pack_frag(sa, 1);
            bf16x8 vf[4][2];
#pragma unroll
            for (int eb = 0; eb < 4; ++eb)
#pragma unroll
                for (int s2 = 0; s2 < 2; ++s2) { const int row = eb * 32 + r32; vf[eb][s2] = *(const LAS bf16x8*)(vb_ + row * 256 + (((4 * cl + 2 * s2 + hh) ^ (row & 15)) << 4)); }
#pragma unroll
            for (int eb = 0; eb < 4; ++eb) { o[eb] = o[eb] * alpha; o[eb] = MFMA32(vf[eb][0], pf0, o[eb]); o[eb] = MFMA32(vf[eb][1], pf1, o[eb]); }
        }
    }
    __syncthreads();
    LAS unsigned char* wl = lds + 65536 + w * 8192;
    const float inv = 1.0f / lrun;
#pragma unroll
    for (int eb = 0; eb < 4; ++eb)
#pragma unroll
        for (int a = 0; a < 4; ++a) { u32x2 wv; wv.x = cvtpk(o[eb][4 * a] * inv, o[eb][4 * a + 1] * inv); wv.y = cvtpk(o[eb][4 * a + 2] * inv, o[eb][4 * a + 3] * inv);
            *(LAS u32x2*)(wl + r32 * 256 + (((eb * 4 + a) ^ (r32 & 15)) << 4) + 8 * hh) = wv; }
    LDS_WAIT();
    bf16* OG = (bf16*)(ws + WS_OG) + (size_t)g * M * 1024 + (size_t)(prow0 + 32 * w) * 1024 + head * 128;
#pragma unroll
    for (int j = 0; j < 8; ++j) { const int row = 4 * j + (lane >> 4), pc = (lane & 15) ^ (row & 15);
        const u32x4 v = *(const LAS u32x4*)(wl + row * 256 + ((lane & 15) << 4)); *(GAS u32x4*)(OG + (size_t)row * 1024 + pc * 8) = v; }
    if (hh == 0) ((GAS float*)(ws + WS_LSE))[(size_t)g * M * 8 + (size_t)(prow0 + 32 * w + r32) * 8 + head] = mrun + __builtin_amdgcn_logf(lrun);
    LDS_WAIT(); __syncthreads();
#undef AW_ISSUE
}
__device__ __forceinline__ void p2a_attention(Frame& F, int cw) {
    volatile LAS unsigned* slot = (volatile LAS unsigned*)(F.lds + MISC_OFF + 64);
    for (;;) {
        const int lane = lane_now();
        if (F.wave == 0 && lane == 0) *slot = __hip_atomic_fetch_add((unsigned*)(F.ctl + cw), 1u, RLX_AGENT);
        __syncthreads();
        const unsigned idx = (unsigned)__builtin_amdgcn_readfirstlane((int)*slot);
        __syncthreads();
        if (idx >= 1536u) break;
        attn_wg_item((int)idx, F.ws, F.lds, F.wave, lane);
    }
}

__device__ __forceinline__ void ret_unit(Frame& F, int unit, const float* gn_g) {
    const int b = unit >> 8, h = (unit >> 5) & 7, n = unit & 31, lane = lane_now(), w = F.wave, r32 = lane & 31, hh = lane >> 5;
    unsigned char* ws = F.ws;
    const int tok0 = b * SEQ + n * 128;
    const float lg = LOG2G[h];
    const bf16* QRg = (const bf16*)(ws + WS_QR) + (size_t)tok0 * 2048 + h * 256;
    const bf16* KR = (const bf16*)(ws + WS_KR) + (size_t)tok0 * 2048 + h * 256 + 8 * hh;
    LAS unsigned char* fr = F.lds;
    LAS float* stt = (LAS float*)(F.lds + 20480);
    LAS unsigned char* ql = F.lds + 32768;
    const int kperm = (r32 & ~12) | ((r32 & 4) << 1) | ((r32 & 8) >> 1);
#pragma unroll
    for (int i = 0; i < 8; ++i) { const int row = 2 * (w * 8 + i) + hh, pc = r32 ^ (row & 15);
        __builtin_amdgcn_global_load_lds((const unsigned*)(QRg + (size_t)row * 2048 + pc * 8), (LAS unsigned*)(ql + (w * 8 + i) * 1024), 16, 0, 0); }
    VM_WAIT(); __syncthreads();
#define RU_QFRAG(qb, ks) (*(const LAS bf16x8*)(ql + ((qb) * 32 + r32) * 512 + ((((2 * (ks) + hh)) ^ (r32 & 15)) << 4)))
    for (int k = w; k < 10; k += 8) {
        const int jb = k < 4 ? 0 : (k < 7 ? 1 : (k < 9 ? 2 : 3)), qb = k < 4 ? k : (k < 7 ? k - 3 : (k < 9 ? k - 5 : 3));
        f32x16 x = zero16();
        const bf16* ka = KR + (size_t)(jb * 32 + kperm) * 2048;
        bf16x8 kf[16];
#pragma unroll
        for (int ks = 0; ks < 16; ++ks) kf[ks] = ldg8(ka + ks * 16);
#pragma unroll
        for (int ks = 0; ks < 16; ++ks) x = MFMA32(kf[ks], RU_QFRAG(qb, ks), x);
#pragma unroll
        for (int i = 0; i < 16; ++i) { const int j = jb * 32 + (i & 7) + 8 * hh + 16 * (i >> 3), q = qb * 32 + r32, df = q - j; x[i] = df >= 0 ? x[i] * fexp2((float)df * lg) : 0.f; }
        *(LAS bf16x8*)(fr + ((k * 2 + 0) * 64 + lane) * 16) = pack_frag(x, 0);
        *(LAS bf16x8*)(fr + ((k * 2 + 1) * 64 + lane) * 16) = pack_frag(x, 1);
    }
    __syncthreads();
    f32x16 acc[2][4];
#pragma unroll
    for (int e2 = 0; e2 < 2; ++e2)
#pragma unroll
        for (int qb = 0; qb < 4; ++qb) acc[e2][qb] = zero16();
    if (n > 0) {
        const bf16* ST = (const bf16*)(ws + WS_ST) + ((size_t)(((b * 8 + h) * 32 + n)) * 512 + w * 64 + r32) * 256 + 8 * hh;
        bf16x8 sa[2][4][2];
#pragma unroll
        for (int j = 0; j < 4; ++j) { sa[0][j][0] = ldg8(ST + j * 16); sa[0][j][1] = ldg8(ST + (size_t)32 * 256 + j * 16); }
#pragma unroll
        for (int kb = 0; kb < 4; ++kb) {
            if (kb < 3) {
#pragma unroll
                for (int j = 0; j < 4; ++j) { sa[(kb + 1) & 1][j][0] = ldg8(ST + ((kb + 1) * 4 + j) * 16); sa[(kb + 1) & 1][j][1] = ldg8(ST + (size_t)32 * 256 + ((kb + 1) * 4 + j) * 16); } }
#pragma unroll
            for (int j = 0; j < 4; ++j) { const int ks = kb * 4 + j;
#pragma unroll
                for (int qb = 0; qb < 4; ++qb) { const bf16x8 bq = RU_QFRAG(qb, ks); acc[0][qb] = MFMA32(sa[kb & 1][j][0], bq, acc[0][qb]); acc[1][qb] = MFMA32(sa[kb & 1][j][1], bq, acc[1][qb]); } }
        }
#pragma unroll
        for (int qb = 0; qb < 4; ++qb) { const float sc = fexp2((float)(qb * 32 + r32 + 1) * lg); acc[0][qb] = acc[0][qb] * sc; acc[1][qb] = acc[1][qb] * sc; }
    }
    {
        const bf16* VT = (const bf16*)(ws + WS_VTR) + (size_t)(h * 512 + w * 64 + r32) * M + tok0 + 8 * hh;
#pragma unroll
        for (int jb = 0; jb < 4; ++jb)
#pragma unroll
            for (int s = 0; s < 2; ++s) {
                const bf16x8 a0 = ldg8(VT + jb * 32 + 16 * s), a1 = ldg8(VT + (size_t)32 * M + jb * 32 + 16 * s);
#pragma unroll
                for (int qb = jb; qb < 4; ++qb) { const int k = (jb == 0 ? 0 : (jb == 1 ? 4 : (jb == 2 ? 7 : 9))) + (qb - jb);
                    const bf16x8 p = *(const LAS bf16x8*)(fr + ((k * 2 + s) * 64 + lane) * 16);
                    acc[0][qb] = MFMA32(a0, p, acc[0][qb]); acc[1][qb] = MFMA32(a1, p, acc[1][qb]); }
            }
    }
#pragma unroll
    for (int qb = 0; qb < 4; ++qb) { float s1 = 0.f, s2 = 0.f;
#pragma unroll
        for (int e2 = 0; e2 < 2; ++e2)
#pragma unroll
            for (int i = 0; i < 16; ++i) { const float v = acc[e2][qb][i]; s1 += v; s2 += v * v; }
        s1 += __shfl_xor(s1, 32); s2 += __shfl_xor(s2, 32);
        if (hh == 0) { stt[((qb * 32 + r32) * 8 + w) * 2] = s1; stt[((qb * 32 + r32) * 8 + w) * 2 + 1] = s2; } }
    __syncthreads();
    const float* gp = gn_g + h * 512 + w * 64 + 4 * hh;
#pragma unroll
    for (int qb = 0; qb < 4; ++qb) { float s1 = 0.f, s2 = 0.f;
#pragma unroll
        for (int ww = 0; ww < 8; ++ww) { s1 += stt[((qb * 32 + r32) * 8 + ww) * 2]; s2 += stt[((qb * 32 + r32) * 8 + ww) * 2 + 1]; }
        const float mu = s1 * (1.0f / 512.0f), var = fmaxf(s2 * (1.0f / 512.0f) - mu * mu, 0.f), rstd = 1.0f / sqrtf(var + GN_EPS);
        const size_t ro = (size_t)(tok0 + qb * 32 + r32) * D + h * 512 + w * 64 + 4 * hh;
        const bf16* gr = (const bf16*)(ws + WS_GR) + ro; bf16* og = (bf16*)(ws + WS_RG) + ro;
#pragma unroll
        for (int e2 = 0; e2 < 2; ++e2)
#pragma unroll
            for (int a = 0; a < 4; ++a) { const f32x4 gg = *(const GAS f32x4*)(gp + e2 * 32 + 8 * a); const u32x2 sg = *(const GAS u32x2*)(gr + e2 * 32 + 8 * a);
                const float v0 = (acc[e2][qb][4 * a] - mu) * rstd * gg[0] * bflo(sg.x), v1 = (acc[e2][qb][4 * a + 1] - mu) * rstd * gg[1] * bfhi(sg.x);
                const float v2 = (acc[e2][qb][4 * a + 2] - mu) * rstd * gg[2] * bflo(sg.y), v3 = (acc[e2][qb][4 * a + 3] - mu) * rstd * gg[3] * bfhi(sg.y);
                u32x2 wv; wv.x = cvtpk(v0, v1); wv.y = cvtpk(v2, v3); *(GAS u32x2*)(og + e2 * 32 + 8 * a) = wv; } }
    __syncthreads();
}
#undef RU_QFRAG
__device__ __forceinline__ void combine_token(unsigned char* ws, int t, int lane) {
    const int b = t >> 12, sp = t & (SEQ - 1), head = lane >> 3;
    float lse[3]; size_t prow[3];
#pragma unroll
    for (int g = 0; g < 3; ++g) { const int sh = 2 * g, d = 1 << sh, L = SEQ >> sh; prow[g] = (size_t)(b * d + (sp & (d - 1))) * L + (sp >> sh);
        lse[g] = ((const GAS float*)(ws + WS_LSE))[(size_t)g * M * 8 + prow[g] * 8 + head]; }
    const float mx = fmaxf(lse[0], fmaxf(lse[1], lse[2]));
    float wg[3], ws_ = 0.f;
#pragma unroll
    for (int g = 0; g < 3; ++g) { wg[g] = fexp2(lse[g] - mx); ws_ += wg[g]; }
    const float inv = 1.0f / ws_;
    f32x4 o[4];
#pragma unroll
    for (int j = 0; j < 4; ++j) o[j] = (f32x4){0.f, 0.f, 0.f, 0.f};
#pragma unroll
    for (int g = 0; g < 3; ++g) { const bf16* og = (const bf16*)(ws + WS_OG) + (size_t)g * M * 1024 + prow[g] * 1024 + lane * 16;
        const u32x4 w0 = *(const GAS u32x4*)og, w1 = *(const GAS u32x4*)(og + 8); f32x4 a0, a1, a2, a3; ge::unpack8(w0, a0, a1); ge::unpack8(w1, a2, a3);
        const float f = wg[g] * inv; o[0] += a0 * f; o[1] += a1 * f; o[2] += a2 * f; o[3] += a3 * f; }
    bf16* oa = (bf16*)(ws + WS_OATT) + (size_t)t * 1024 + lane * 16;
    *(GAS u32x4*)oa = ge::pack8(o[0], o[1]); *(GAS u32x4*)(oa + 8) = ge::pack8(o[2], o[3]);
}
__device__ __forceinline__ void p2b_phase(Frame& F, const float* gn_g) {
    for (int u = F.c; u < 1024; u += F.G) ret_unit(F, u, gn_g);
    const int gw = F.c * NWAVES + F.wave, NGW = F.G * NWAVES;
    { const int lane = lane_now(); for (int t = gw; t < M; t += NGW) combine_token(F.ws, t, lane); }
}

template <int MODE>
__device__ __forceinline__ void lnb_rows(Frame& F, const bf16* src, float* dstf, bf16* dstb, unsigned char* dst8, float* stat, const float* gam, const float* bet) {
    const int gw = F.c * NWAVES + F.wave, NGW = F.G * NWAVES, lane = lane_now();
    if (MODE == 1 && gw < D / 64) { const int col = gw * 64 + lane; ((GAS f32x2_t*)stat)[M + col] = (f32x2_t){ALPHA * gam[col], ALPHA * bet[col]}; }
    for (int m = gw; m < M; m += NGW) {
        const GAS u32x4* xr = (const GAS u32x4*)(src + (size_t)m * D) + lane;
        f32x4 v[16]; float s = 0.f;
#pragma unroll
        for (int j = 0; j < 8; ++j) { const u32x4 w = MODE == 0 ? __builtin_nontemporal_load(xr + 64 * j) : xr[64 * j]; ge::unpack8(w, v[2 * j], v[2 * j + 1]);
            s += ((v[2 * j][0] + v[2 * j][1]) + (v[2 * j][2] + v[2 * j][3])) + ((v[2 * j + 1][0] + v[2 * j + 1][1]) + (v[2 * j + 1][2] + v[2 * j + 1][3])); }
        const float mean = wave_sum(s) * (1.0f / D); float s2 = 0.f;
#pragma unroll
        for (int j = 0; j < 16; ++j) { v[j] = v[j] - mean; s2 += (v[j][0] * v[j][0] + v[j][1] * v[j][1]) + (v[j][2] * v[j][2] + v[j][3] * v[j][3]); }
        const float rstd = 1.0f / sqrtf(wave_sum(s2) * (1.0f / D) + LN_EPS);
        if (MODE == 1 && lane == 0) ((GAS f32x2_t*)stat)[m] = (f32x2_t){mean, rstd};
        GAS f32x4* of = (GAS f32x4*)(dstf + (size_t)m * D) + 2 * lane;
        GAS u32x4* ob = (GAS u32x4*)(dstb + (size_t)m * D) + lane;
        GAS u32x2* o8 = (GAS u32x2*)(dst8 + (size_t)m * D) + lane;
#pragma unroll
        for (int j = 0; j < 8; ++j) { const GAS f32x4* gp = (const GAS f32x4*)gam + 2 * (lane + 64 * j); const GAS f32x4* bp = (const GAS f32x4*)bet + 2 * (lane + 64 * j);
            const f32x4 y0 = v[2 * j] * rstd * gp[0] + bp[0], y1 = v[2 * j + 1] * rstd * gp[1] + bp[1];
            if (MODE == 1) { ob[64 * j] = ge::pack8(y0, y1); u32x2 w8; w8.x = pk_fp8x4(y0[0], y0[1], y0[2], y0[3]); w8.y = pk_fp8x4(y1[0], y1[1], y1[2], y1[3]); o8[64 * j] = w8; }
            else { __builtin_nontemporal_store(y0, of + 128 * j); __builtin_nontemporal_store(y1, of + 128 * j + 1); } }
    }
}

__device__ __forceinline__ void kpt_transpose(Frame& F) {
    const int lane = lane_now(), gw = F.c * NWAVES + F.wave, NGW = F.G * NWAVES;
    LAS unsigned short* scr = (LAS unsigned short*)(F.lds + F.wave * 16384);
    const bf16* KR = (const bf16*)(F.ws + WS_KR); bf16* KT = (bf16*)(F.ws + WS_KPT);
    for (int it = gw; it < (M / 64) * (2048 / 64); it += NGW) {
        const int tb = it >> 5, fb = it & 31, tok0 = tb * 64, f0 = fb * 64, h = fb >> 2;
#pragma unroll
        for (int i = 0; i < 8; ++i) { const int r = 8 * i + (lane >> 3), cpos = (lane & 7) * 8;
            const u32x4 v = *(const GAS u32x4*)(KR + (size_t)(tok0 + r) * 2048 + f0 + cpos);
            LAS unsigned* d = (LAS unsigned*)(scr + r * 66 + cpos); d[0] = v.x; d[1] = v.y; d[2] = v.z; d[3] = v.w; }
        LDS_WAIT(); asm volatile("" ::: "memory");
        const float lg = LOG2G[h]; const int tpos = (lane & 7) * 8;
        float dec[8];
#pragma unroll
        for (int j = 0; j < 8; ++j) dec[j] = fexp2((float)(127 - ((tok0 + tpos + j) & 127)) * lg);
#pragma unroll
        for (int i = 0; i < 8; ++i) { const int f = 8 * i + (lane >> 3); float v[8];
#pragma unroll
            for (int j = 0; j < 8; ++j) v[j] = __uint_as_float((unsigned)scr[(tpos + j) * 66 + f] << 16) * dec[j];
            u32x4 o; o.x = cvtpk(v[0], v[1]); o.y = cvtpk(v[2], v[3]); o.z = cvtpk(v[4], v[5]); o.w = cvtpk(v[6], v[7]);
            *(GAS u32x4*)(KT + (size_t)(f0 + f) * M + tok0 + tpos) = o; }
        LDS_WAIT(); asm volatile("" ::: "memory");
    }
}

__global__ void __launch_bounds__(NWAVES * 64, 2) mk_fwd(Args args) {
    extern __shared__ __attribute__((aligned(16))) unsigned char lds[];
    Frame F;
    F.lds = (LAS unsigned char*)lds;
    F.wave = __builtin_amdgcn_readfirstlane((int)(threadIdx.x >> 6));
    F.G = gridDim.x; F.c = blockIdx.x; F.ws = args.ws;
    F.ctl = (gu32*)(args.ws + WS_CTL);
    volatile LAS unsigned* MISC = (volatile LAS unsigned*)(F.lds + MISC_OFF);
    for (int u = threadIdx.x; u < (LDS_BYTES - LDSCTL_OFF) / 4; u += NWAVES * 64) ((LAS unsigned*)(F.lds + LDSCTL_OFF))[u] = 0u;
    __syncthreads();
    XcdBarrier bar; bar.bar = (unsigned*)(F.ctl + CW_BAR); bar.x = 0; bar.st = nullptr; bar.wave = F.wave;
    if (MK_N_LAUNCHES == 1) bar = xcd_barrier_post((unsigned*)(F.ctl + CW_BAR), MISC + 8, F.wave);
    const int lo = args.ph_lo, hi = args.ph_hi;
#ifndef ST_MASK
#define ST_MASK 0xff
#endif
#define SM(k) ((ST_MASK >> (k)) & 1)
#ifndef DUP_MASK
#define DUP_MASK 0
#endif
#define DUP(k) ((DUP_MASK >> (k)) & 1)
#ifndef PH_MASK
#define PH_MASK 0x7ff
#endif
#define IN(k) (((PH_MASK >> (k)) & 1) && lo <= (k) && (k) < hi)
#define SEAM(k) do { if (IN(k) && IN((k) + 1)) xcd_barrier(bar); } while (0)

    if (IN(0)) { p0_prologue(F, args); if (DUP(0)) { xcd_barrier(bar); p0_prologue(F, args); } SEAM(0); }
    const unsigned* utab = (const unsigned*)(args.ws + WS_TAB) + (size_t)F.c * NSLOT * ge::GU_DW;
#define UT(slot) (utab + (slot) * ge::GU_DW)
    if (IN(1)) {
        ge::gemm_stream<ge::K_SCALE, 0, true>(F.lds, UT(SL_P1), 9, F.wave);
        ge::gemm_stream<ge::K_SCALE, 0>(F.lds, UT(SL_P1 + 9), 4, F.wave);
        ge::gemm_stream<ge::K_ROT, 0>(F.lds, UT(SL_P1B), 4, F.wave);
        ge::gemm_stream<ge::K_SILU, 0>(F.lds, UT(SL_P1D), 4, F.wave);
        ge::gemm_stream<ge::K_SIG, 0, true>(F.lds, UT(SL_P1E), 8 - GX, F.wave);
        if (DUP(1)) { xcd_barrier(bar); ge::gemm_stream<ge::K_SCALE, 0, true>(F.lds, UT(SL_P1), 9, F.wave); ge::gemm_stream<ge::K_SCALE, 0>(F.lds, UT(SL_P1 + 9), 4, F.wave); ge::gemm_stream<ge::K_ROT, 0>(F.lds, UT(SL_P1B), 4, F.wave); ge::gemm_stream<ge::K_SILU, 0>(F.lds, UT(SL_P1D), 4, F.wave); ge::gemm_stream<ge::K_SIG, 0, true>(F.lds, UT(SL_P1E), 8 - GX, F.wave); }
        SEAM(1); }
    if (IN(2)) { kpt_transpose(F); if (DUP(2)) { xcd_barrier(bar); kpt_transpose(F); } SEAM(2); }
    if (IN(3)) { ge::gemm_stream<ge::K_SCALE, 2>(F.lds, UT(SL_SCAN), 31, F.wave); ge::gemm_stream<ge::K_SIG, 0, true>(F.lds, UT(SL_G2), 2 * GX, F.wave); late_weights_queue(F, args, CW_WORK + 64); p2a_attention(F, CW_WORK); if (DUP(11)) { xcd_barrier(bar); p2a_attention(F, CW_WORK + 128); } if (DUP(12)) { xcd_barrier(bar); late_weights_queue(F, args, CW_WORK + 192); } if (DUP(3)) { xcd_barrier(bar); ge::gemm_stream<ge::K_SCALE, 2>(F.lds, UT(SL_SCAN), 31, F.wave); } SEAM(3); }
    if (IN(4)) { p2b_phase(F, args.in[5]); if (DUP(4)) { xcd_barrier(bar); p2b_phase(F, args.in[5]); } SEAM(4); }
    if (IN(5)) { ge::gemm_stream<ge::K_SCALE, 0>(F.lds, UT(SL_P3), 4, F.wave); ge::gemm_stream<ge::K_FIN, 1>(F.lds, UT(SL_P3B), 8, F.wave); if (DUP(5)) { xcd_barrier(bar); ge::gemm_stream<ge::K_SCALE, 0>(F.lds, UT(SL_P3), 4, F.wave); ge::gemm_stream<ge::K_FIN, 1>(F.lds, UT(SL_P3B), 8, F.wave); } SEAM(5); }
    if (IN(6)) { ge::gemm_stream<ge::K_WO, 0>(F.lds, UT(SL_P4), 4, F.wave); if (DUP(6)) { xcd_barrier(bar); ge::gemm_stream<ge::K_WO, 0>(F.lds, UT(SL_P4), 4, F.wave); } SEAM(6); }
    if (IN(7)) { lnb_rows<1>(F, (const bf16*)(args.ws + WS_P1B), nullptr, (bf16*)(args.ws + WS_H1B), args.ws + WS_X8, (float*)(args.ws + WS_STAT), args.in[7], args.in[8]); if (DUP(7)) { xcd_barrier(bar); lnb_rows<1>(F, (const bf16*)(args.ws + WS_P1B), nullptr, (bf16*)(args.ws + WS_H1B), args.ws + WS_X8, (float*)(args.ws + WS_STAT), args.in[7], args.in[8]); } SEAM(7); }
    if (IN(8)) { ge::gemm_stream<ge::K_SWIGLU, 0>(F.lds, UT(SL_P5), 22, F.wave); if (DUP(8)) { xcd_barrier(bar); ge::gemm_stream<ge::K_SWIGLU, 0>(F.lds, UT(SL_P5), 22, F.wave); } ge::gemm_stream<ge::K_PLE, 0, true>(F.lds, UT(SL_P5B), 5, F.wave); SEAM(8); }
    if (IN(9)) { ge::gemm_stream<ge::K_DOWN, 0, false, true>(F.lds, UT(SL_P6), 4, F.wave); if (DUP(9)) { xcd_barrier(bar); ge::gemm_stream<ge::K_DOWN, 0>(F.lds, UT(SL_P6), 4, F.wave); } SEAM(9); }
    if (IN(10)) { lnb_rows<0>(F, (const bf16*)(args.ws + WS_P2B), args.out, nullptr, nullptr, nullptr, args.in[14], args.in[15]); }
#undef IN
#undef SEAM
}

extern "C" void kernel_launch(void* const* d_in, const int* in_sizes, int n_in, void* d_out, int out_size, void* d_ws, size_t ws_size, hipStream_t stream) {
    static int grid = 0;
    if (grid == 0) {
        if (n_in != 16 || out_size != M * D || ws_size < WS_END) { fprintf(stderr, "kernel_launch: unexpected problem (n_in %d, out %d, ws %zu); nothing launched\n", n_in, out_size, ws_size); grid = -1; return; }
        int dev = 0, cus = 0;
        if (hipGetDevice(&dev) != hipSuccess || hipDeviceGetAttribute(&cus, hipDeviceAttributeMultiprocessorCount, dev) != hipSuccess) { grid = -1; return; }
        if (hipFuncSetAttribute((const void*)mk_fwd, hipFuncAttributeMaxDynamicSharedMemorySize, LDS_BYTES) != hipSuccess) { fprintf(stderr, "kernel_launch: hipFuncSetAttribute failed\n"); grid = -1; return; }
        int per_cu = 0;
        if (hipOccupancyMaxActiveBlocksPerMultiprocessor(&per_cu, (const void*)mk_fwd, NWAVES * 64, LDS_BYTES) != hipSuccess || per_cu < 1) fprintf(stderr, "kernel_launch: occupancy query reports %d\n", per_cu);
        (void)hipGetLastError();
        grid = cus;
        if (grid != 256) { fprintf(stderr, "kernel_launch: built for 256 CUs, device has %d\n", grid); }
    }
    if (grid < 0) return;
    (void)hipMemsetAsync((char*)d_ws + WS_CTL, 0, CTL_ZERO_BYTES, stream);
    Args a{};
    for (int i = 0; i < 16; ++i) a.in[i] = (const float*)d_in[i];
    a.out = (float*)d_out; a.ws = (unsigned char*)d_ws;
    if (MK_N_LAUNCHES == 1) { a.ph_lo = 0; a.ph_hi = N_PHASES; hipLaunchKernelGGL(mk_fwd, dim3(grid), dim3(NWAVES * 64), LDS_BYTES, stream, a); }
    else for (int p = 0; p < N_PHASES; ++p) { a.ph_lo = p; a.ph_hi = p + 1; hipLaunchKernelGGL(mk_fwd, dim3(grid), dim3(NWAVES * 64), LDS_BYTES, stream, a); }
}
```
